# Optimizing an MI355X kernel written in HIP

```python
import math
import jax, jax.numpy as jnp
from jax import lax
import numpy as np

D_MODEL = 1024
BATCH = 8
SEQ = 2048
DEPTH = 2

CHUNK = 64
D_MIX = D_MODEL
GLA_HEADS = 4
GLA_WIDTH = D_MIX // 2
GLA_DV = GLA_WIDTH // GLA_HEADS
GLA_DK = GLA_DV // 2
GLA_GATE_RANK = 16
GLA_GATE_NORMALIZER = 16.0
SGU_WIDTH = D_MIX - GLA_WIDTH
SGU_GROUPS = 4
SGU_GROUP_DIM = SGU_WIDTH // SGU_GROUPS
SGU_WINDOW = 128
COL_Q = GLA_HEADS * GLA_DK
COL_K = GLA_HEADS * GLA_DK
COL_V = GLA_WIDTH
COL_R = GLA_WIDTH
COL_A = GLA_GATE_RANK
COL_SU = SGU_WIDTH
COL_SV = SGU_WIDTH
IN_COLS = COL_Q + COL_K + COL_V + COL_R + COL_A + COL_SU + COL_SV
PEER_HEADS = 8
PEER_NKEYS = 128
PEER_EXPERTS = PEER_NKEYS * PEER_NKEYS
PEER_TOPK = 16
PEER_DQ = 256
PEER_DQ_HALF = PEER_DQ // 2
PEER_HK = PEER_HEADS * PEER_TOPK
PEER_TOKEN_BLOCK = 128
LN_EPS = 1e-5
ALPHA = (2.0 * DEPTH) ** 0.25
BETA = (8.0 * DEPTH) ** -0.25

kernel_name = "hybrid_gla_gmlp_peer_deepnorm"


def _layer_norm(x, g, b):
    xf = x.astype(jnp.float32)
    mu = jnp.mean(xf, axis=-1, keepdims=True)
    var = jnp.mean(jnp.square(xf - mu), axis=-1, keepdims=True)
    y = (xf - mu) * lax.rsqrt(var + LN_EPS)
    return (y * g.astype(jnp.float32) + b.astype(jnp.float32)).astype(x.dtype)


def _rms_norm(x, g):
    xf = x.astype(jnp.float32)
    y = xf * lax.rsqrt(jnp.mean(jnp.square(xf), axis=-1, keepdims=True) + LN_EPS)
    return (y * g.astype(jnp.float32)).astype(x.dtype)


def _gla_chunked(q, k, v, logg):
    B, S, H, DK = q.shape
    DV = v.shape[-1]
    N = S // CHUNK

    def to_chunks(t):
        return t.astype(jnp.float32).reshape(B, N, CHUNK, H, t.shape[-1]).transpose(1, 0, 3, 2, 4)

    qc, kc, vc, gc = to_chunks(q), to_chunks(k), to_chunks(v), to_chunks(logg)
    causal = jnp.tril(jnp.ones((CHUNK, CHUNK), dtype=bool))

    def step(state, inp):
        qb, kb, vb, gb = inp
        bcum = jnp.cumsum(gb, axis=2)
        diff = bcum[:, :, :, None, :] - bcum[:, :, None, :, :]
        decay = jnp.exp(jnp.where(causal[:, :, None], diff, -jnp.inf))
        attn = jnp.einsum('bhtk,bhsk,bhtsk->bhts', qb, kb, decay)
        o = jnp.einsum('bhts,bhsv->bhtv', attn, vb) + \
            jnp.einsum('bhtk,bhkv->bhtv', qb * jnp.exp(bcum), state)
        b_last = bcum[:, :, -1:, :]
        state = jnp.exp(b_last[:, :, 0, :])[..., None] * state + \
            jnp.einsum('bhsk,bhsv->bhkv', kb * jnp.exp(b_last - bcum), vb)
        return state, o

    s0 = jnp.zeros((B, H, DK, DV), jnp.float32)
    _, o = lax.scan(step, s0, (qc, kc, vc, gc))
    return o.transpose(1, 0, 3, 2, 4).reshape(B, S, H, DV).astype(v.dtype)


def _spatial_gating(u_pre, v_pre, ln_g, ln_b, w_s, b_s):
    B, S, _ = u_pre.shape
    u = jax.nn.gelu(u_pre, approximate=False)
    v = _layer_norm(jax.nn.gelu(v_pre, approximate=False), ln_g, ln_b)
    blk = jnp.arange(SGU_WINDOW) // CHUNK
    mask = blk[None, :] <= blk[:, None]
    w = jnp.where(mask[None], w_s, 0)
    vb = v.reshape(B, S // SGU_WINDOW, SGU_WINDOW, SGU_GROUPS, SGU_GROUP_DIM)
    sv = jnp.einsum('gts,bnsgc->bntgc', w, vb) + b_s.T[:, :, None]
    return u * sv.reshape(B, S, SGU_WIDTH)


def _peer(x, wq, k1, k2, u_tab, v_tab):
    B, S, D = x.shape
    T = B * S
    xt = x.reshape(T, D)
    q = (xt @ wq).reshape(T, PEER_HEADS, 2, PEER_DQ_HALF)
    s1 = jnp.einsum('thd,nd->thn', q[:, :, 0], k1)
    s2 = jnp.einsum('thd,nd->thn', q[:, :, 1], k2)
    v1, i1 = lax.top_k(s1, PEER_TOPK)
    v2, i2 = lax.top_k(s2, PEER_TOPK)
    cand = (v1[..., :, None] + v2[..., None, :]).reshape(T, PEER_HEADS, PEER_TOPK * PEER_TOPK)
    cidx = (i1[..., :, None] * PEER_NKEYS + i2[..., None, :]).reshape(T, PEER_HEADS, PEER_TOPK * PEER_TOPK)
    sc, pos = lax.top_k(cand, PEER_TOPK)
    eidx = jnp.take_along_axis(cidx, pos, axis=-1).reshape(T, PEER_HK)
    gate = jax.nn.softmax(sc.astype(jnp.float32), axis=-1).astype(x.dtype).reshape(T, PEER_HK)
    nb = T // PEER_TOKEN_BLOCK

    def expert_block(args):
        xb, ib, gb = args
        ub = jnp.take(u_tab, ib, axis=0)
        act = jax.nn.gelu(jnp.einsum('td,tkd->tk', xb, ub), approximate=False)
        vb = jnp.take(v_tab, ib, axis=0)
        return jnp.einsum('tk,tkd->td', gb * act, vb)

    out = lax.map(expert_block, (xt.reshape(nb, PEER_TOKEN_BLOCK, D),
                                 eidx.reshape(nb, PEER_TOKEN_BLOCK, PEER_HK),
                                 gate.reshape(nb, PEER_TOKEN_BLOCK, PEER_HK)))
    return out.reshape(B, S, D)


def _mixer(x, w_in, w_gate_up, b_gate, gla_norm_g, sgu_ln_g, sgu_ln_b, sgu_w, sgu_b, w_out):
    B, S, _ = x.shape
    h = x @ w_in
    splits = np.cumsum([COL_Q, COL_K, COL_V, COL_R, COL_A, COL_SU]).tolist()
    q, k, v, r, a, su, sv = jnp.split(h, splits, axis=-1)
    logg = jax.nn.log_sigmoid((a @ w_gate_up + b_gate).astype(jnp.float32)) / GLA_GATE_NORMALIZER
    q = q.reshape(B, S, GLA_HEADS, GLA_DK) * (GLA_DK ** -0.5)
    k = k.reshape(B, S, GLA_HEADS, GLA_DK)
    v = v.reshape(B, S, GLA_HEADS, GLA_DV)
    o = _gla_chunked(q, k, v, logg.reshape(B, S, GLA_HEADS, GLA_DK))
    o = _rms_norm(o, gla_norm_g).reshape(B, S, GLA_WIDTH) * jax.nn.silu(r)
    g = _spatial_gating(su, sv, sgu_ln_g, sgu_ln_b, sgu_w, sgu_b)
    return jnp.concatenate([o, g], axis=-1) @ w_out


def setup_inputs(seed: int = 0) -> dict:
    key = jax.random.key(seed)
    ks = jax.random.split(key, 24)
    L, D = DEPTH, D_MODEL
    nrm = lambda k, shape, s: jax.random.normal(k, shape, jnp.float32) * s
    return {
        "x": nrm(ks[0], (BATCH, SEQ, D), 1.0),
        "ln_in_g": 1.0 + nrm(ks[1], (D,), 0.02),
        "ln_in_b": nrm(ks[2], (D,), 0.02),
        "w_in": nrm(ks[3], (L, D, IN_COLS), D ** -0.5),
        "w_gate_up": nrm(ks[4], (L, GLA_GATE_RANK, GLA_HEADS * GLA_DK), GLA_GATE_RANK ** -0.5),
        "b_gate": nrm(ks[5], (L, GLA_HEADS * GLA_DK), 0.1),
        "gla_norm_g": 1.0 + nrm(ks[6], (L, GLA_DV), 0.02),
        "sgu_ln_g": 1.0 + nrm(ks[7], (L, SGU_WIDTH), 0.02),
        "sgu_ln_b": nrm(ks[8], (L, SGU_WIDTH), 0.02),
        "sgu_w": nrm(ks[9], (L, SGU_GROUPS, SGU_WINDOW, SGU_WINDOW), SGU_WINDOW ** -0.5),
        "sgu_b": 1.0 + nrm(ks[10], (L, SGU_GROUPS, SGU_WINDOW), 0.02),
        "w_out": nrm(ks[11], (L, D_MIX, D), BETA * D_MIX ** -0.5),
        "ln1_g": 1.0 + nrm(ks[12], (L, D), 0.02),
        "ln1_b": nrm(ks[13], (L, D), 0.02),
        "peer_wq": nrm(ks[14], (L, D, PEER_HEADS * PEER_DQ), D ** -0.5),
        "peer_k1": nrm(ks[15], (L, PEER_NKEYS, PEER_DQ_HALF), PEER_DQ_HALF ** -0.5),
        "peer_k2": nrm(ks[16], (L, PEER_NKEYS, PEER_DQ_HALF), PEER_DQ_HALF ** -0.5),
        "peer_u": nrm(ks[17], (L, PEER_EXPERTS, D), D ** -0.5),
        "peer_v": nrm(ks[18], (L, PEER_EXPERTS, D), BETA * PEER_HEADS ** -0.5),
        "ln2_g": 1.0 + nrm(ks[19], (L, D), 0.02),
        "ln2_b": nrm(ks[20], (L, D), 0.02),
    }


def reference(x, ln_in_g, ln_in_b, w_in, w_gate_up, b_gate, gla_norm_g, sgu_ln_g, sgu_ln_b,
              sgu_w, sgu_b, w_out, ln1_g, ln1_b, peer_wq, peer_k1, peer_k2, peer_u, peer_v,
              ln2_g, ln2_b):
    h = _layer_norm(x, ln_in_g, ln_in_b)
    for l in range(DEPTH):
        mix = _mixer(h, w_in[l], w_gate_up[l], b_gate[l], gla_norm_g[l], sgu_ln_g[l], sgu_ln_b[l],
                     sgu_w[l], sgu_b[l], w_out[l])
        h = _layer_norm(ALPHA * h + mix, ln1_g[l], ln1_b[l])
        ffn = _peer(h, peer_wq[l], peer_k1[l], peer_k2[l], peer_u[l], peer_v[l])
        h = _layer_norm(ALPHA * h + ffn, ln2_g[l], ln2_b[l])
    return h
```

```cpp
#include <hip/hip_runtime.h>
#include <hip/hip_cooperative_groups.h>
#include <cstdio>
namespace cg = cooperative_groups;

typedef unsigned short u16;
using bf16x8 = __attribute__((ext_vector_type(8))) short;
using f32x4  = __attribute__((ext_vector_type(4))) float;
using u32x4  = __attribute__((ext_vector_type(4))) unsigned;
typedef __bf16 bf16x2_t __attribute__((ext_vector_type(2)));

constexpr int T_TOK = 16384;
constexpr int DM = 1024;
constexpr int INC = 2576;
constexpr int INCP = 2688;
constexpr int PLD = 2688;
constexpr int NL = 2;
constexpr int NEXP = 16384;
constexpr float LN_EPS = 1e-5f;
constexpr float ALPHA = 1.4142135623730951f;
constexpr int C_Q = 0, C_K = 256, C_V = 512, C_R = 1024, C_A = 1536, C_SU = 1552, C_SV = 2064;

constexpr size_t AL(size_t x) { return (x + 255) & ~(size_t)255; }
constexpr size_t WS_WIN  = 0;
constexpr size_t WS_WOUT = WS_WIN  + AL((size_t)NL * INCP * DM * 2);
constexpr size_t WS_WQ   = WS_WOUT + AL((size_t)NL * DM * DM * 2);
constexpr size_t WS_K1   = WS_WQ   + AL((size_t)NL * 2048 * DM * 2);
constexpr size_t WS_K2   = WS_K1   + AL((size_t)NL * 128 * 128 * 2);
constexpr size_t WS_SGUW = WS_K2   + AL((size_t)NL * 128 * 128 * 2);
constexpr size_t WS_UB   = WS_SGUW + AL((size_t)NL * 4 * 128 * 128 * 2);
constexpr size_t WS_VB   = WS_UB   + AL((size_t)NL * NEXP * DM * 2);
constexpr size_t WS_H    = WS_VB   + AL((size_t)NL * NEXP * DM * 2);
constexpr size_t WS_HB   = WS_H    + AL((size_t)T_TOK * DM * 4);
constexpr size_t WS_P    = WS_HB   + AL((size_t)T_TOK * DM * 2);
constexpr size_t WS_MC   = WS_P    + AL((size_t)T_TOK * PLD * 2);
constexpr size_t WS_KC   = WS_MC   + AL((size_t)T_TOK * DM * 2);
constexpr size_t WS_ST   = WS_KC   + AL((size_t)32 * 32 * 64 * 128 * 4);
constexpr size_t WS_DEC  = WS_ST   + AL((size_t)32 * 32 * 64 * 128 * 2);
constexpr size_t WS_EIDX = WS_DEC  + AL((size_t)32 * 32 * 64 * 4);
constexpr size_t WS_GATE = WS_EIDX + AL((size_t)T_TOK * 128 * 4);
constexpr size_t WS_QG   = WS_GATE + AL((size_t)T_TOK * 128 * 4);
constexpr size_t WS_BAR  = WS_QG + AL((size_t)T_TOK * 2048 * 2);
constexpr size_t WS_XBAR = WS_BAR + 256;
constexpr size_t WS_SU   = WS_XBAR + 16384 - 256;
constexpr size_t WS_SV   = WS_SU + (size_t)NL * NEXP * 4;
constexpr size_t WS_END  = WS_SV + (size_t)NL * NEXP * 4;

constexpr size_t WS_QDKD = WS_UB + ((size_t)40 << 20);
constexpr int LDS_BYTES = 77824;
constexpr int NPHASE = 1 + NL * 9;

struct Params {
  const float* in[21];
  float* out; unsigned char* ws; int ph_lo, ph_hi;
};
enum { I_X = 0, I_LNIG, I_LNIB, I_WIN, I_WGU, I_BG, I_GNG, I_SLG, I_SLB, I_SW, I_SB, I_WOUT, I_L1G, I_L1B, I_WQ, I_K1, I_K2, I_U, I_V, I_L2G, I_L2B };

__device__ __forceinline__ int ltid() { int t = threadIdx.x; asm volatile("" : "+v"(t)); return t; }
__device__ __forceinline__ unsigned cvtpk(float lo, float hi) { bf16x2_t v; v[0] = (__bf16)lo; v[1] = (__bf16)hi; return __builtin_bit_cast(unsigned, v); }
__device__ __forceinline__ u16 f2bf(float f) { return __builtin_bit_cast(u16, (__bf16)f); }
__device__ __forceinline__ float bf2f(u16 h) { return __uint_as_float(((unsigned)h) << 16); }
__device__ __forceinline__ float bflo(unsigned w) { return __uint_as_float(w << 16); }
__device__ __forceinline__ float bfhi(unsigned w) { return __uint_as_float(w & 0xffff0000u); }
__device__ __forceinline__ float gelu_f(float x) { return 0.5f * x * (1.f + erff(x * 0.70710678118654752f)); }
__device__ __forceinline__ float logsig(float x) { return fminf(x, 0.f) - log1pf(__expf(-fabsf(x))); }
__device__ __forceinline__ float wave_sum(float v) {
#pragma unroll
  for (int o = 32; o; o >>= 1) v += __shfl_xor(v, o);
  return v;
}
__device__ __forceinline__ float dot2(unsigned w, unsigned x, float acc) {
  return __builtin_amdgcn_fdot2_f32_bf16(__builtin_bit_cast(bf16x2_t, w), __builtin_bit_cast(bf16x2_t, x), acc, false);
}
__device__ __forceinline__ unsigned fkey(float f) { unsigned u = __float_as_uint(f); return u ^ ((u >> 31) ? 0xffffffffu : 0x80000000u); }
__device__ __forceinline__ float funkey(unsigned k) { unsigned u = k ^ ((k >> 31) ? 0x80000000u : 0xffffffffu); return __uint_as_float(u); }

#define GLD_B128(dst, ptr) dst = *(const u32x4*)(ptr)
#define GLD_B32(dst, ptr)  dst = *(const unsigned*)(ptr)
#define VM_WAIT0() asm volatile("s_waitcnt vmcnt(0)" ::: "memory")
__device__ __forceinline__ void unpack8(const u32x4& w, float (&f)[8]) {
  f[0] = bflo(w.x); f[1] = bfhi(w.x); f[2] = bflo(w.y); f[3] = bfhi(w.y); f[4] = bflo(w.z); f[5] = bfhi(w.z); f[6] = bflo(w.w); f[7] = bfhi(w.w);
}
__device__ __forceinline__ void ln_row(float (&y)[16], const float* __restrict__ g, const float* __restrict__ b, int lane,
                                       float* __restrict__ outf, u16* __restrict__ outb) {
  float s = 0.f;
#pragma unroll
  for (int i = 0; i < 16; ++i) s += y[i];
  const float mean = wave_sum(s) * (1.f / 1024.f);
  float q = 0.f;
#pragma unroll
  for (int i = 0; i < 16; ++i) { y[i] -= mean; q += y[i] * y[i]; }
  const float rstd = rsqrtf(wave_sum(q) * (1.f / 1024.f) + LN_EPS);
#pragma unroll
  for (int hseg = 0; hseg < 2; ++hseg) {
    const int c0 = hseg * 512 + lane * 8;
    const float4 g0 = *(const float4*)(g + c0), g1 = *(const float4*)(g + c0 + 4);
    const float4 b0 = *(const float4*)(b + c0), b1 = *(const float4*)(b + c0 + 4);
    float4 o0, o1;
    o0.x = y[hseg * 8 + 0] * rstd * g0.x + b0.x; o0.y = y[hseg * 8 + 1] * rstd * g0.y + b0.y;
    o0.z = y[hseg * 8 + 2] * rstd * g0.z + b0.z; o0.w = y[hseg * 8 + 3] * rstd * g0.w + b0.w;
    o1.x = y[hseg * 8 + 4] * rstd * g1.x + b1.x; o1.y = y[hseg * 8 + 5] * rstd * g1.y + b1.y;
    o1.z = y[hseg * 8 + 6] * rstd * g1.z + b1.z; o1.w = y[hseg * 8 + 7] * rstd * g1.w + b1.w;
    *(float4*)(outf + c0) = o0; *(float4*)(outf + c0 + 4) = o1;
    if (outb) {
      uint4 w; w.x = cvtpk(o0.x, o0.y); w.y = cvtpk(o0.z, o0.w); w.z = cvtpk(o1.x, o1.y); w.w = cvtpk(o1.z, o1.w);
      *(uint4*)(outb + c0) = w;
    }
  }
}
__device__ __forceinline__ void load_row16(const float* __restrict__ src, int lane, float (&y)[16]) {
#pragma unroll
  for (int hseg = 0; hseg < 2; ++hseg) {
    const float4 a = *(const float4*)(src + hseg * 512 + lane * 8), b = *(const float4*)(src + hseg * 512 + lane * 8 + 4);
    y[hseg * 8 + 0] = a.x; y[hseg * 8 + 1] = a.y; y[hseg * 8 + 2] = a.z; y[hseg * 8 + 3] = a.w;
    y[hseg * 8 + 4] = b.x; y[hseg * 8 + 5] = b.y; y[hseg * 8 + 6] = b.z; y[hseg * 8 + 7] = b.w;
  }
}

template <int BM, int BN, int BK, class Epi>
__device__ __forceinline__ void gemm_tile(const u16* __restrict__ A, const u16* __restrict__ B, const int K,
                                          const int m0, const int n0, unsigned char* lds, Epi& epi) {
  constexpr int LDK = BK;
  constexpr int MT = BM / 32, NT = BN / 32;
  constexpr int CPR = BK / 8;
  constexpr int A_CH = BM * CPR / 256, B_CH = BN * CPR / 256;
  constexpr int STAGE = (BM + BN) * LDK * 2;
  const int tid = ltid(), lane = tid & 63, wave = tid >> 6;
  const int wm = wave >> 1, wn = wave & 1;
  const int lr = lane & 15, lq = lane >> 4;
  f32x4 acc[MT][NT];
#pragma unroll
  for (int i = 0; i < MT; ++i)
#pragma unroll
    for (int j = 0; j < NT; ++j) acc[i][j] = (f32x4){0.f, 0.f, 0.f, 0.f};
  u32x4 ra[2][A_CH], rb[2][B_CH];
  const int KT = K / BK;
#define GT_ISSUE(set, tile) do { const int k0_ = (((tile) < KT) ? (tile) : (KT - 1)) * BK; \
    _Pragma("unroll") for (int i = 0; i < A_CH; ++i) { const int c = tid + i * 256, row = c / CPR, kc = c % CPR; const u16* gp = A + (size_t)(m0 + row) * K + k0_ + kc * 8; \
      asm volatile("global_load_dwordx4 %0, %1, off" : "=&v"(ra[set][i]) : "v"(gp) : "memory"); } \
    _Pragma("unroll") for (int i = 0; i < B_CH; ++i) { const int c = tid + i * 256, row = c / CPR, kc = c % CPR; const u16* gp = B + (size_t)(n0 + row) * K + k0_ + kc * 8; \
      asm volatile("global_load_dwordx4 %0, %1, off" : "=&v"(rb[set][i]) : "v"(gp) : "memory"); } } while (0)
#define GT_STORE(set, stage) do { u16* dA = (u16*)(lds + (stage) * STAGE); u16* dB = dA + BM * LDK; \
    _Pragma("unroll") for (int i = 0; i < A_CH; ++i) { const int c = tid + i * 256, row = c / CPR, kc = c % CPR; *(u32x4*)(dA + row * LDK + ((kc ^ (row & 7)) * 8)) = ra[set][i]; } \
    _Pragma("unroll") for (int i = 0; i < B_CH; ++i) { const int c = tid + i * 256, row = c / CPR, kc = c % CPR; *(u32x4*)(dB + row * LDK + ((kc ^ (row & 7)) * 8)) = rb[set][i]; } } while (0)
#define GT_COMPUTE(stage) do { const u16* sA = (const u16*)(lds + (stage) * STAGE); const u16* sB = sA + BM * LDK; \
    _Pragma("unroll") for (int ks = 0; ks < BK / 32; ++ks) { bf16x8 af[MT], bfr[NT]; \
      _Pragma("unroll") for (int i = 0; i < MT; ++i) af[i] = *(const bf16x8*)(sA + (wm * (BM / 2) + i * 16 + lr) * LDK + (((ks * 4 + lq) ^ (lr & 7)) * 8)); \
      _Pragma("unroll") for (int j = 0; j < NT; ++j) bfr[j] = *(const bf16x8*)(sB + (wn * (BN / 2) + j * 16 + lr) * LDK + (((ks * 4 + lq) ^ (lr & 7)) * 8)); \
      _Pragma("unroll") for (int i = 0; i < MT; ++i) _Pragma("unroll") for (int j = 0; j < NT; ++j) acc[i][j] = __builtin_amdgcn_mfma_f32_16x16x32_bf16(af[i], bfr[j], acc[i][j], 0, 0, 0); } } while (0)
  GT_ISSUE(0, 0);
  asm volatile("s_waitcnt vmcnt(0)" ::: "memory");
  GT_STORE(0, 0);
  GT_ISSUE(1, 1);
  __syncthreads();
#pragma unroll 1
  for (int kt = 0; kt < KT; kt += 2) {
    const bool m2 = (kt + 2 < KT);
    if (m2) GT_ISSUE(0, kt + 2);
    __builtin_amdgcn_sched_barrier(0);
    GT_COMPUTE(0);
    __builtin_amdgcn_sched_barrier(0);
    if (m2) asm volatile("s_waitcnt vmcnt(8)" ::: "memory"); else asm volatile("s_waitcnt vmcnt(0)" ::: "memory");
    GT_STORE(1, 1);
    __syncthreads();
    if (m2) GT_ISSUE(1, kt + 3);
    __builtin_amdgcn_sched_barrier(0);
    GT_COMPUTE(1);
    __builtin_amdgcn_sched_barrier(0);
    if (m2) { asm volatile("s_waitcnt vmcnt(8)" ::: "memory"); GT_STORE(0, 0); }
    __syncthreads();
  }
#undef GT_ISSUE
#undef GT_STORE
#undef GT_COMPUTE
  {
    int slot = 0;
#pragma unroll
    for (int i = 0; i < MT; ++i)
#pragma unroll
      for (int j = 0; j < NT; ++j)
#pragma unroll
        for (int r = 0; r < 4; ++r) epi.pre(wm * (BM / 2) + i * 16 + lq * 4 + r, wn * (BN / 2) + j * 16 + lr, slot++);
    slot = 0;
#pragma unroll
    for (int i = 0; i < MT; ++i)
#pragma unroll
      for (int j = 0; j < NT; ++j)
#pragma unroll
        for (int r = 0; r < 4; ++r)
          epi(wm * (BM / 2) + i * 16 + lq * 4 + r, wn * (BN / 2) + j * 16 + lr, acc[i][j][r], slot++);
  }
}

__device__ __forceinline__ void transpose_tile(const float* __restrict__ src, int Ksrc, int Nsrc, u16* __restrict__ dst, int kt, int nt, float* tl) {
  const int tid = ltid();
  const int k0 = kt * 64, n0 = nt * 64;
  u32x4 r[4];
#pragma unroll
  for (int m = 0; m < 4; ++m) {
    const int i = tid + m * 256, kk = i >> 4, n4 = (i & 15) * 4;
    const int nn = (n0 + n4 < Nsrc) ? (n0 + n4) : 0;
    const float* gp = src + (size_t)(k0 + kk) * Nsrc + nn;
    GLD_B128(r[m], gp);
  }
  VM_WAIT0();
#pragma unroll
  for (int m = 0; m < 4; ++m) {
    const int i = tid + m * 256, kk = i >> 4, n4 = (i & 15) * 4;
    const bool ok = (n0 + n4 < Nsrc);
    tl[kk * 65 + n4 + 0] = ok ? __uint_as_float(r[m].x) : 0.f; tl[kk * 65 + n4 + 1] = ok ? __uint_as_float(r[m].y) : 0.f;
    tl[kk * 65 + n4 + 2] = ok ? __uint_as_float(r[m].z) : 0.f; tl[kk * 65 + n4 + 3] = ok ? __uint_as_float(r[m].w) : 0.f;
  }
  __syncthreads();
  for (int i = tid; i < 2048; i += 256) {
    const int nn = i >> 5, kp = i & 31;
    const unsigned w = cvtpk(tl[(2 * kp) * 65 + nn], tl[(2 * kp + 1) * 65 + nn]);
    *(unsigned*)(dst + (size_t)(n0 + nn) * Ksrc + k0 + 2 * kp) = w;
  }
  __syncthreads();
}
__device__ __forceinline__ void convert8(const float* __restrict__ src, u16* __restrict__ dst, size_t n8, size_t gtid, size_t gn) {
  for (size_t i = gtid; i < n8; i += gn) {
    const float4 a = *(const float4*)(src + i * 8), b = *(const float4*)(src + i * 8 + 4);
    uint4 w; w.x = cvtpk(a.x, a.y); w.y = cvtpk(a.z, a.w); w.z = cvtpk(b.x, b.y); w.w = cvtpk(b.z, b.w);
    *(uint4*)(dst + i * 8) = w;
  }
}
__device__ __forceinline__ void phase_prologue(const Params& p, unsigned char* lds) {
  unsigned char* ws = p.ws;
  const int tid = ltid(), lane = tid & 63, wave = tid >> 6;
  const int nb = gridDim.x, bid = blockIdx.x;
  float* tl = (float*)lds;
  constexpr int PER_L = 672 + 256 + 512;
  for (int it = bid; it < NL * PER_L; it += nb) {
    const int l = it / PER_L; int r = it % PER_L;
    if (r < 672) { transpose_tile(p.in[I_WIN] + (size_t)l * DM * INC, DM, INC, (u16*)(ws + WS_WIN) + (size_t)l * INCP * DM, r / 42, r % 42, tl); }
    else if (r < 928) { r -= 672; transpose_tile(p.in[I_WOUT] + (size_t)l * DM * DM, DM, DM, (u16*)(ws + WS_WOUT) + (size_t)l * DM * DM, r / 16, r % 16, tl); }
    else { r -= 928; transpose_tile(p.in[I_WQ] + (size_t)l * DM * 2048, DM, 2048, (u16*)(ws + WS_WQ) + (size_t)l * 2048 * DM, r / 32, r % 32, tl); }
  }
  const size_t gtid = (size_t)bid * 256 + tid, gn = (size_t)nb * 256;
  for (int tb = 0; tb < 2 * NL; ++tb) {
    const float* src = p.in[(tb & 1) ? I_V : I_U] + (size_t)(tb >> 1) * NEXP * DM;
    unsigned char* dst = ws + ((tb & 1) ? WS_VB : WS_UB) + (size_t)(tb >> 1) * NEXP * DM;
    u16* sdst = (u16*)(ws + WS_SU) + (size_t)(tb >> 1) * NEXP * 2 + (tb & 1);
    for (int row0 = (bid * 4 + wave) * 4; row0 < NEXP; row0 += nb * 16) {
      float4 v[4][4];
#pragma unroll
      for (int r = 0; r < 4; ++r)
#pragma unroll
        for (int q = 0; q < 4; ++q) v[r][q] = *(const float4*)(src + (size_t)(row0 + r) * DM + lane * 16 + q * 4);
#pragma unroll
      for (int r = 0; r < 4; ++r) {
        float m = 0.f;
#pragma unroll
        for (int q = 0; q < 4; ++q) m = fmaxf(m, fmaxf(fmaxf(fabsf(v[r][q].x), fabsf(v[r][q].y)), fmaxf(fabsf(v[r][q].z), fabsf(v[r][q].w))));
#pragma unroll
        for (int o = 32; o; o >>= 1) m = fmaxf(m, __shfl_xor(m, o));
        m = fmaxf(m, 1e-30f);
        const u16 dq = f2bf(m * (1.f / 240.f));
        const float sc = 1.f / bf2f(dq);
        uint4 w; int t0;
        t0 = 0; t0 = __builtin_amdgcn_cvt_pk_fp8_f32(v[r][0].x * sc, v[r][0].y * sc, t0, false); t0 = __builtin_amdgcn_cvt_pk_fp8_f32(v[r][0].z * sc, v[r][0].w * sc, t0, true); w.x = (unsigned)t0;
        t0 = 0; t0 = __builtin_amdgcn_cvt_pk_fp8_f32(v[r][1].x * sc, v[r][1].y * sc, t0, false); t0 = __builtin_amdgcn_cvt_pk_fp8_f32(v[r][1].z * sc, v[r][1].w * sc, t0, true); w.y = (unsigned)t0;
        t0 = 0; t0 = __builtin_amdgcn_cvt_pk_fp8_f32(v[r][2].x * sc, v[r][2].y * sc, t0, false); t0 = __builtin_amdgcn_cvt_pk_fp8_f32(v[r][2].z * sc, v[r][2].w * sc, t0, true); w.z = (unsigned)t0;
        t0 = 0; t0 = __builtin_amdgcn_cvt_pk_fp8_f32(v[r][3].x * sc, v[r][3].y * sc, t0, false); t0 = __builtin_amdgcn_cvt_pk_fp8_f32(v[r][3].z * sc, v[r][3].w * sc, t0, true); w.w = (unsigned)t0;
        *(uint4*)(dst + (size_t)(row0 + r) * DM + lane * 16) = w;
        if (lane == 0) sdst[(size_t)(row0 + r) * 2] = dq;
      }
    }
  }
  convert8(p.in[I_K1], (u16*)(ws + WS_K1), (size_t)NL * 128 * 128 / 8, gtid, gn);
  convert8(p.in[I_K2], (u16*)(ws + WS_K2), (size_t)NL * 128 * 128 / 8, gtid, gn);
  for (size_t i = gtid; i < (size_t)NL * 4 * 128 * 128; i += gn) {
    const int s = (int)(i & 127), t = (int)((i >> 7) & 127);
    const float v = ((s >> 6) <= (t >> 6)) ? p.in[I_SW][i] : 0.f;
    ((u16*)(ws + WS_SGUW))[i] = f2bf(v);
  }
  float* H = (float*)(ws + WS_H); u16* HB = (u16*)(ws + WS_HB);
  for (int row = bid * 4 + wave; row < T_TOK; row += nb * 4) {
    float y[16];
    load_row16(p.in[I_X] + (size_t)row * DM, lane, y);
    ln_row(y, p.in[I_LNIG], p.in[I_LNIB], lane, H + (size_t)row * DM, HB + (size_t)row * DM);
  }
}

template <int NT>
__device__ __forceinline__ bool xcd_tile(int j, int& mb, int& nb) {
  const int xcd = blockIdx.x & 7;
  const int grp = j / (8 * NT), r = j % (8 * NT);
  mb = xcd * 16 + grp * 8 + (r & 7); nb = r >> 3;
  return grp < 2;
}
struct EpiInproj {
  u16* P; int m0, n0;
  __device__ __forceinline__ void pre(int, int, int) {}
  __device__ __forceinline__ void operator()(int r, int c, float v, int) const {
    const int col = n0 + c;
    if (col < INC) {
      if (col < 256) v *= 0.125f;
      else if (col >= C_SU) v = gelu_f(v);
      P[(size_t)(m0 + r) * PLD + col] = f2bf(v);
    }
  }
};
__device__ __forceinline__ void phase_inproj(const Params& p, int l, unsigned char* lds) {
  const u16* A = (const u16*)(p.ws + WS_HB);
  const u16* B = (const u16*)(p.ws + WS_WIN) + (size_t)l * INCP * DM;
  u16* P = (u16*)(p.ws + WS_P);
  constexpr int NB_N = INCP / 128;
  for (int j = blockIdx.x >> 3; ; j += gridDim.x >> 3) {
    int mb, nbk; if (!xcd_tile<NB_N>(j, mb, nbk)) break;
    EpiInproj e{P, mb * 128, nbk * 128};
    gemm_tile<128, 128, 64>(A, B, DM, mb * 128, nbk * 128, lds, e);
  }
}

typedef short v4i16_t __attribute__((ext_vector_type(4)));
__device__ __forceinline__ bf16x8 tr_bfrag(const u16* img, int ld, int k0, int n0, int lr, int lq) {
  const u16* a0 = img + (k0 + 8 * lq + (lr >> 2)) * ld + n0 + 4 * (lr & 3);
  const v4i16_t lo = __builtin_amdgcn_ds_read_tr16_b64_v4i16((__attribute__((address_space(3))) v4i16_t*)a0);
  const v4i16_t hi = __builtin_amdgcn_ds_read_tr16_b64_v4i16((__attribute__((address_space(3))) v4i16_t*)(a0 + 4 * ld));
  return __builtin_shufflevector(lo, hi, 0, 1, 2, 3, 4, 5, 6, 7);
}
__device__ __forceinline__ void gla_bcum(const u16* __restrict__ Pm, const float* __restrict__ wgu, const float* __restrict__ bg,
                                         int tok0, int h, float* bc, float* a_s, float* wg_s, float* tot) {
  const int tid = ltid();
  {
    const int t = tid >> 2, q = tid & 3, r = tid >> 4, k4 = (tid & 15) * 4;
    const uint2 aw = *(const uint2*)(Pm + (size_t)(tok0 + t) * PLD + C_A + q * 4);
    const float4 wv = *(const float4*)(wgu + r * 256 + h * 64 + k4);
    const float bgv = bg[h * 64 + (tid & 63)];
    a_s[t * 16 + q * 4 + 0] = bflo(aw.x); a_s[t * 16 + q * 4 + 1] = bfhi(aw.x); a_s[t * 16 + q * 4 + 2] = bflo(aw.y); a_s[t * 16 + q * 4 + 3] = bfhi(aw.y);
    wg_s[r * 64 + k4 + 0] = wv.x; wg_s[r * 64 + k4 + 1] = wv.y; wg_s[r * 64 + k4 + 2] = wv.z; wg_s[r * 64 + k4 + 3] = wv.w;
    if (tid < 64) wg_s[1024 + tid] = bgv;
  }
  __syncthreads();
  {
    const int k = tid & 63, qt = tid >> 6;
    float wcol[16];
#pragma unroll
    for (int r = 0; r < 16; ++r) wcol[r] = wg_s[r * 64 + k];
    const float bgk = wg_s[1024 + k];
    float lg[16];
    float c = 0.f;
#pragma unroll
    for (int j = 0; j < 16; ++j) {
      const float4* ap = (const float4*)(a_s + (qt * 16 + j) * 16);
      const float4 a0 = ap[0], a1 = ap[1], a2 = ap[2], a3 = ap[3];
      float sacc = bgk;
      sacc += a0.x * wcol[0]; sacc += a0.y * wcol[1]; sacc += a0.z * wcol[2]; sacc += a0.w * wcol[3];
      sacc += a1.x * wcol[4]; sacc += a1.y * wcol[5]; sacc += a1.z * wcol[6]; sacc += a1.w * wcol[7];
      sacc += a2.x * wcol[8]; sacc += a2.y * wcol[9]; sacc += a2.z * wcol[10]; sacc += a2.w * wcol[11];
      sacc += a3.x * wcol[12]; sacc += a3.y * wcol[13]; sacc += a3.z * wcol[14]; sacc += a3.w * wcol[15];
      c += logsig(sacc) * (1.f / 16.f);
      lg[j] = c;
    }
    tot[qt * 64 + k] = c;
    __syncthreads();
    float pre = 0.f;
    for (int q = 0; q < qt; ++q) pre += tot[q * 64 + k];
#pragma unroll
    for (int j = 0; j < 16; ++j) bc[(qt * 16 + j) * 65 + k] = lg[j] + pre;
  }
  __syncthreads();
}

__device__ __forceinline__ void gla_passA_item(const Params& p, int l, int item, unsigned char* lds) {
  const int tid = ltid(), lane = tid & 63, wave = tid >> 6, lr = lane & 15, lq = lane >> 4;
  const int bh = item >> 5, n = item & 31, b = bh >> 2, h = bh & 3;
  const int tok0 = b * 2048 + n * 64;
  const u16* Pm = (const u16*)(p.ws + WS_P);
  float* bc = (float*)lds;
  u16* kdT = (u16*)(lds + 16640);
  u16* vT = (u16*)(lds + 16640 + 9216);
  float* a_s = (float*)(lds + 16640 + 9216 + 18432);
  float* wg_s = a_s + 1024;
  float* tot = wg_s + 1088;
  gla_bcum(Pm, p.in[I_WGU] + (size_t)l * 16 * 256, p.in[I_BG] + (size_t)l * 256, tok0, h, bc, a_s, wg_s, tot);
  {
    u32x4 rk[2], rv[4], rq[2];
#pragma unroll
    for (int m = 0; m < 2; ++m) { const int i = tid + m * 256, s = i >> 3, k0 = (i & 7) * 8; const u16* gp = Pm + (size_t)(tok0 + s) * PLD + C_K + h * 64 + k0; GLD_B128(rk[m], gp); const u16* gq = gp - (C_K - C_Q); GLD_B128(rq[m], gq); }
#pragma unroll
    for (int m = 0; m < 4; ++m) { const int i = tid + m * 256, s = i >> 4, v0 = (i & 15) * 8; const u16* gp = Pm + (size_t)(tok0 + s) * PLD + C_V + h * 128 + v0; GLD_B128(rv[m], gp); }
    VM_WAIT0();
#pragma unroll
    for (int m = 0; m < 2; ++m) {
      const int i = tid + m * 256, s = i >> 3, k0 = (i & 7) * 8;
      float f[8]; unpack8(rk[m], f);
      float fq[8]; unpack8(rq[m], fq);
      unsigned wq[4], wk[4];
      {
        unsigned wl[4];
#pragma unroll
        for (int j = 0; j < 4; ++j)
          wl[j] = cvtpk(f[2 * j] * __expf(bc[63 * 65 + k0 + 2 * j] - bc[s * 65 + k0 + 2 * j]), f[2 * j + 1] * __expf(bc[63 * 65 + k0 + 2 * j + 1] - bc[s * 65 + k0 + 2 * j + 1]));
        *(uint4*)(kdT + s * 72 + k0) = make_uint4(wl[0], wl[1], wl[2], wl[3]);
      }
#pragma unroll
      for (int j = 0; j < 4; ++j) {
        const float b0 = bc[s * 65 + k0 + 2 * j], b1 = bc[s * 65 + k0 + 2 * j + 1];
        wq[j] = cvtpk(fq[2 * j] * __expf(b0), fq[2 * j + 1] * __expf(b1));
        wk[j] = cvtpk(f[2 * j] * __expf(-b0), f[2 * j + 1] * __expf(-b1));
      }
      u16* qdkd = (u16*)(p.ws + WS_QDKD) + (size_t)item * 2 * 4096;
      *(uint4*)(qdkd + s * 64 + k0) = make_uint4(wq[0], wq[1], wq[2], wq[3]);
      *(uint4*)(qdkd + 4096 + s * 64 + k0) = make_uint4(wk[0], wk[1], wk[2], wk[3]);
    }
#pragma unroll
    for (int m = 0; m < 4; ++m) {
      const int i = tid + m * 256, s = i >> 4, v0 = (i & 15) * 8;
      *(u32x4*)(vT + s * 136 + v0) = rv[m];
    }
  }
  __syncthreads();
  f32x4 acc[8];
#pragma unroll
  for (int j = 0; j < 8; ++j) acc[j] = (f32x4){0.f, 0.f, 0.f, 0.f};
#pragma unroll
  for (int ks = 0; ks < 2; ++ks) {
    const bf16x8 a = tr_bfrag(kdT, 72, ks * 32, wave * 16, lr, lq);
#pragma unroll
    for (int j = 0; j < 8; ++j) {
      const bf16x8 bb = tr_bfrag(vT, 136, ks * 32, j * 16, lr, lq);
      acc[j] = __builtin_amdgcn_mfma_f32_16x16x32_bf16(a, bb, acc[j], 0, 0, 0);
    }
  }
  float* KC = (float*)(p.ws + WS_KC) + (size_t)item * 64 * 128;
#pragma unroll
  for (int j = 0; j < 8; ++j)
#pragma unroll
    for (int r = 0; r < 4; ++r) KC[(wave * 16 + lq * 4 + r) * 128 + j * 16 + lr] = acc[j][r];
  if (tid < 64) ((float*)(p.ws + WS_DEC))[item * 64 + tid] = __expf(bc[63 * 65 + tid]);
  __syncthreads();
}

__device__ __forceinline__ void sgu_item(const Params& p, int l, int item, unsigned char* lds) {
  const int tid = ltid(), lane = tid & 63, wave = tid >> 6, lr = lane & 15, lq = lane >> 4;
  const int win = item >> 2, g = item & 3;
  const int tok0 = win * 128;
  const u16* Pm = (const u16*)(p.ws + WS_P);
  float* mean_s = (float*)lds; float* rstd_s = mean_s + 128;
  u16* vT = (u16*)(lds + 1024);
#pragma unroll 1
  for (int b8 = 0; b8 < 2; ++b8) {
    u32x4 rw[16];
#pragma unroll
    for (int i = 0; i < 16; ++i) { const int s = wave * 32 + b8 * 16 + i; const u16* gp = Pm + (size_t)(tok0 + s) * PLD + C_SV + lane * 8; GLD_B128(rw[i], gp); }
    VM_WAIT0();
#pragma unroll
    for (int i = 0; i < 16; ++i) {
      const int s = wave * 32 + b8 * 16 + i;
      float f[8]; unpack8(rw[i], f);
      const float sm = f[0] + f[1] + f[2] + f[3] + f[4] + f[5] + f[6] + f[7];
      const float mean = wave_sum(sm) * (1.f / 512.f);
      float sq = 0.f;
#pragma unroll
      for (int j = 0; j < 8; ++j) { const float d = f[j] - mean; sq += d * d; }
      const float var = wave_sum(sq) * (1.f / 512.f);
      if (lane == 0) { mean_s[s] = mean; rstd_s[s] = rsqrtf(var + LN_EPS); }
    }
  }
  __syncthreads();
  float bsv[8];
#pragma unroll
  for (int i = 0; i < 2; ++i)
#pragma unroll
    for (int r = 0; r < 4; ++r) bsv[i * 4 + r] = p.in[I_SB][((size_t)l * 4 + g) * 128 + wave * 32 + i * 16 + lq * 4 + r];
  u32x4 ru[8];
  {
    const int c0 = (tid & 15) * 8;
    const float* lng = p.in[I_SLG] + (size_t)l * 512 + g * 128 + c0;
    const float* lnb = p.in[I_SLB] + (size_t)l * 512 + g * 128 + c0;
    u32x4 rv[8];
#pragma unroll
    for (int m = 0; m < 8; ++m) { const int i = tid + m * 256, s = i >> 4; const u16* gv = Pm + (size_t)(tok0 + s) * PLD + C_SV + g * 128 + c0; const u16* gu = Pm + (size_t)(tok0 + s) * PLD + C_SU + g * 128 + c0; GLD_B128(rv[m], gv); GLD_B128(ru[m], gu); }
    const float4 ga = *(const float4*)(lng), gb = *(const float4*)(lng + 4), ba = *(const float4*)(lnb), bb = *(const float4*)(lnb + 4);
    const float gg[8] = {ga.x, ga.y, ga.z, ga.w, gb.x, gb.y, gb.z, gb.w}, bbv[8] = {ba.x, ba.y, ba.z, ba.w, bb.x, bb.y, bb.z, bb.w};
    VM_WAIT0();
#pragma unroll
    for (int m = 0; m < 8; ++m) {
      const int i = tid + m * 256, s = i >> 4;
      float f[8]; unpack8(rv[m], f);
      const float mu = mean_s[s], rs = rstd_s[s];
      unsigned wn[4];
#pragma unroll
      for (int j = 0; j < 4; ++j) wn[j] = cvtpk((f[2 * j] - mu) * rs * gg[2 * j] + bbv[2 * j], (f[2 * j + 1] - mu) * rs * gg[2 * j + 1] + bbv[2 * j + 1]);
      *(uint4*)(vT + s * 136 + c0) = make_uint4(wn[0], wn[1], wn[2], wn[3]);
    }
  }
  __syncthreads();
  const u16* W = (const u16*)(p.ws + WS_SGUW) + ((size_t)l * 4 + g) * 128 * 128;
  f32x4 acc[2][8];
#pragma unroll
  for (int i = 0; i < 2; ++i)
#pragma unroll
    for (int j = 0; j < 8; ++j) acc[i][j] = (f32x4){0.f, 0.f, 0.f, 0.f};
  const int nks = (wave < 2) ? 2 : 4;
  for (int ks = 0; ks < nks; ++ks) {
    bf16x8 a[2];
#pragma unroll
    for (int i = 0; i < 2; ++i) a[i] = *(const bf16x8*)(W + (size_t)(wave * 32 + i * 16 + lr) * 128 + ks * 32 + lq * 8);
#pragma unroll
    for (int j = 0; j < 8; ++j) {
      const bf16x8 bb = tr_bfrag(vT, 136, ks * 32, j * 16, lr, lq);
#pragma unroll
      for (int i = 0; i < 2; ++i) acc[i][j] = __builtin_amdgcn_mfma_f32_16x16x32_bf16(a[i], bb, acc[i][j], 0, 0, 0);
    }
  }
  const float* bs = p.in[I_SB] + ((size_t)l * 4 + g) * 128;
  u16* MC = (u16*)(p.ws + WS_MC);
  u16* uT = vT;
  __syncthreads();
#pragma unroll
  for (int m = 0; m < 8; ++m) { const int i = tid + m * 256, t = i >> 4, c0 = (i & 15) * 8; *(u32x4*)(uT + t * 136 + c0) = ru[m]; }
  __syncthreads();
#pragma unroll
  for (int i = 0; i < 2; ++i)
#pragma unroll
    for (int r = 0; r < 4; ++r) {
      const int t = wave * 32 + i * 16 + lq * 4 + r;
      const float bias = bsv[i * 4 + r];
#pragma unroll
      for (int j = 0; j < 8; ++j) {
        const int c = j * 16 + lr;
        const float u = bf2f(uT[t * 136 + c]);
        MC[(size_t)(tok0 + t) * DM + 512 + g * 128 + c] = f2bf((acc[i][j][r] + bias) * u);
      }
    }
  __syncthreads();
}

__device__ __forceinline__ void scan_item(const Params& p, int item) {
  const int e = item * 256 + ltid();
  const int bh = e >> 13, k = (e >> 7) & 63, v = e & 127;
  const float* KC = (const float*)(p.ws + WS_KC);
  const float* DEC = (const float*)(p.ws + WS_DEC);
  u16* ST = (u16*)(p.ws + WS_ST);
  float S = 0.f;
#pragma unroll 1
  for (int n8 = 0; n8 < 2; ++n8) {
    unsigned kc[16], dc[16];
#pragma unroll
    for (int j = 0; j < 16; ++j) {
      const int n = n8 * 16 + j;
      const float* gk = KC + ((size_t)(bh * 32 + n) * 64 + k) * 128 + v; const float* gd = DEC + (bh * 32 + n) * 64 + k;
      GLD_B32(kc[j], gk); GLD_B32(dc[j], gd);
    }
    VM_WAIT0();
#pragma unroll
    for (int j = 0; j < 16; ++j) {
      const int n = n8 * 16 + j;
      ST[((size_t)(bh * 32 + n) * 64 + k) * 128 + v] = f2bf(S);
      S = __uint_as_float(dc[j]) * S + __uint_as_float(kc[j]);
    }
  }
}

__device__ __forceinline__ void gla_passC_item(const Params& p, int l, int item, unsigned char* lds) {
  const int tid = ltid(), lane = tid & 63, wave = tid >> 6, lr = lane & 15, lq = lane >> 4;
  const int bh = item >> 5, n = item & 31, b = bh >> 2, h = bh & 3;
  const int tok0 = b * 2048 + n * 64;
  const u16* Pm = (const u16*)(p.ws + WS_P);
  u16* attn = (u16*)lds;
  u16* qd = (u16*)(lds + 16640);
  u16* kd = (u16*)(lds + 16640 + 9216);
  u16* vT = (u16*)(lds + 16640 + 18432);
  u16* stT = (u16*)(lds + 16640 + 36864);
  const u16* ST = (const u16*)(p.ws + WS_ST) + (size_t)item * 64 * 128;
  float gnv[8];
#pragma unroll
  for (int j = 0; j < 8; ++j) gnv[j] = p.in[I_GNG][(size_t)l * 128 + j * 16 + lr];
  u32x4 rr4[4];
  {
    u32x4 rq[2], rk[2], rv[4], rs[4];
    const u16* qdkd = (const u16*)(p.ws + WS_QDKD) + (size_t)item * 2 * 4096;
#pragma unroll
    for (int m = 0; m < 2; ++m) { const int i = tid + m * 256, t = i >> 3, k0 = (i & 7) * 8; const u16* gq = qdkd + t * 64 + k0; const u16* gk = gq + 4096; GLD_B128(rq[m], gq); GLD_B128(rk[m], gk); }
#pragma unroll
    for (int m = 0; m < 4; ++m) { const int i = tid + m * 256, s = i >> 4, v0 = (i & 15) * 8; const u16* gv = Pm + (size_t)(tok0 + s) * PLD + C_V + h * 128 + v0; const u16* gs = ST + s * 128 + v0; const u16* gr = Pm + (size_t)(tok0 + s) * PLD + C_R + h * 128 + v0;
      GLD_B128(rv[m], gv); GLD_B128(rs[m], gs); GLD_B128(rr4[m], gr); }
    VM_WAIT0();
#pragma unroll
    for (int m = 0; m < 2; ++m) {
      const int i = tid + m * 256, t = i >> 3, k0 = (i & 7) * 8;
      *(u32x4*)(qd + t * 72 + k0) = rq[m];
      *(u32x4*)(kd + t * 72 + k0) = rk[m];
    }
#pragma unroll
    for (int m = 0; m < 4; ++m) {
      const int i = tid + m * 256, s = i >> 4, v0 = (i & 15) * 8;
      *(u32x4*)(vT + s * 136 + v0) = rv[m];
      *(u32x4*)(stT + s * 136 + v0) = rs[m];
    }
  }
  __syncthreads();
  {
    f32x4 sa[4];
#pragma unroll
    for (int j = 0; j < 4; ++j) sa[j] = (f32x4){0.f, 0.f, 0.f, 0.f};
#pragma unroll
    for (int ks = 0; ks < 2; ++ks) {
      const bf16x8 a = *(const bf16x8*)(qd + (wave * 16 + lr) * 72 + ks * 32 + lq * 8);
#pragma unroll
      for (int j = 0; j < 4; ++j) {
        const bf16x8 bb = *(const bf16x8*)(kd + (j * 16 + lr) * 72 + ks * 32 + lq * 8);
        sa[j] = __builtin_amdgcn_mfma_f32_16x16x32_bf16(a, bb, sa[j], 0, 0, 0);
      }
    }
#pragma unroll
    for (int j = 0; j < 4; ++j)
#pragma unroll
      for (int r = 0; r < 4; ++r) {
        const int t = wave * 16 + lq * 4 + r, s = j * 16 + lr;
        attn[t * 72 + s] = f2bf((s <= t) ? sa[j][r] : 0.f);
      }
  }
  __syncthreads();
  f32x4 acc[8];
#pragma unroll
  for (int j = 0; j < 8; ++j) acc[j] = (f32x4){0.f, 0.f, 0.f, 0.f};
#pragma unroll
  for (int ks = 0; ks < 2; ++ks) {
    const bf16x8 a = *(const bf16x8*)(attn + (wave * 16 + lr) * 72 + ks * 32 + lq * 8);
#pragma unroll
    for (int j = 0; j < 8; ++j) {
      const bf16x8 bb = tr_bfrag(vT, 136, ks * 32, j * 16, lr, lq);
      acc[j] = __builtin_amdgcn_mfma_f32_16x16x32_bf16(a, bb, acc[j], 0, 0, 0);
    }
  }
#pragma unroll
  for (int ks = 0; ks < 2; ++ks) {
    const bf16x8 a = *(const bf16x8*)(qd + (wave * 16 + lr) * 72 + ks * 32 + lq * 8);
#pragma unroll
    for (int j = 0; j < 8; ++j) {
      const bf16x8 bb = tr_bfrag(stT, 136, ks * 32, j * 16, lr, lq);
      acc[j] = __builtin_amdgcn_mfma_f32_16x16x32_bf16(a, bb, acc[j], 0, 0, 0);
    }
  }
  const float* gn = p.in[I_GNG] + (size_t)l * 128;
  u16* MC = (u16*)(p.ws + WS_MC);
  u16* rT = vT;
  __syncthreads();
#pragma unroll
  for (int m = 0; m < 4; ++m) { const int i = tid + m * 256, t = i >> 4, v0 = (i & 15) * 8; *(u32x4*)(rT + t * 136 + v0) = rr4[m]; }
  __syncthreads();
#pragma unroll
  for (int r = 0; r < 4; ++r) {
    float ss = 0.f;
#pragma unroll
    for (int j = 0; j < 8; ++j) ss += acc[j][r] * acc[j][r];
    ss += __shfl_xor(ss, 1); ss += __shfl_xor(ss, 2); ss += __shfl_xor(ss, 4); ss += __shfl_xor(ss, 8);
    const float rinv = rsqrtf(ss * (1.f / 128.f) + LN_EPS);
    const int t = wave * 16 + lq * 4 + r;
#pragma unroll
    for (int j = 0; j < 8; ++j) {
      const int v = j * 16 + lr;
      const float rr = bf2f(rT[t * 136 + v]);
      const float sil = rr / (1.f + __expf(-rr));
      MC[(size_t)(tok0 + t) * DM + h * 128 + v] = f2bf(acc[j][r] * rinv * gnv[j] * sil);
    }
  }
  __syncthreads();
}

struct EpiOutproj {
  const float* H; float* O; int m0, n0; float hv[64];
  __device__ __forceinline__ void pre(int r, int c, int slot) { hv[slot] = H[(size_t)(m0 + r) * DM + n0 + c]; }
  __device__ __forceinline__ void operator()(int r, int c, float v, int slot) const {
    const size_t idx = (size_t)(m0 + r) * DM + n0 + c;
    O[idx] = ALPHA * hv[slot] + v;
  }
};
__device__ __forceinline__ void phase_outproj(const Params& p, int l, unsigned char* lds) {
  const u16* A = (const u16*)(p.ws + WS_MC);
  const u16* B = (const u16*)(p.ws + WS_WOUT) + (size_t)l * DM * DM;
  for (int j = blockIdx.x >> 3; ; j += gridDim.x >> 3) {
    int mb, nbk; if (!xcd_tile<8>(j, mb, nbk)) break;
    EpiOutproj e; e.H = (const float*)(p.ws + WS_H); e.O = p.out; e.m0 = mb * 128; e.n0 = nbk * 128;
    gemm_tile<128, 128, 64>(A, B, DM, mb * 128, nbk * 128, lds, e);
  }
}
__device__ __forceinline__ void phase_ln1(const Params& p, int l) {
  const int lane = ltid() & 63, wave = ltid() >> 6;
  float* H = (float*)(p.ws + WS_H); u16* HB = (u16*)(p.ws + WS_HB);
  for (int row = blockIdx.x * 4 + wave; row < T_TOK; row += gridDim.x * 4) {
    float y[16];
    load_row16(p.out + (size_t)row * DM, lane, y);
    ln_row(y, p.in[I_L1G] + (size_t)l * DM, p.in[I_L1B] + (size_t)l * DM, lane, H + (size_t)row * DM, HB + (size_t)row * DM);
  }
}

#define CE_DESC(a, b) { const unsigned hi_ = max(a, b), lo_ = min(a, b); a = hi_; b = lo_; }
template <int N>
__device__ __forceinline__ void bitonic_sort_desc(unsigned (&a)[N]) {
#pragma unroll
  for (int k = 2; k <= N; k <<= 1)
#pragma unroll
    for (int j = k >> 1; j > 0; j >>= 1)
#pragma unroll
      for (int i = 0; i < N; ++i) {
        const int l = i ^ j;
        if (l > i) {
          const unsigned hi = max(a[i], a[l]), lo = min(a[i], a[l]);
          if ((i & k) == 0) { a[i] = hi; a[l] = lo; } else { a[i] = lo; a[l] = hi; }
        }
      }
}
__device__ __forceinline__ void merge16_group4(unsigned (&a)[32]) {
#pragma unroll
  for (int step = 1; step <= 2; step <<= 1) {
    unsigned bq[16];
#pragma unroll
    for (int i = 0; i < 16; ++i) bq[i] = (unsigned)__shfl_xor((int)a[15 - i], step);
#pragma unroll
    for (int i = 0; i < 16; ++i) a[i] = max(a[i], bq[i]);
#pragma unroll
    for (int k = 8; k >= 1; k >>= 1)
#pragma unroll
      for (int i = 0; i < 16; ++i) if ((i & k) == 0) CE_DESC(a[i], a[i | k]);
  }
}
__device__ __forceinline__ void topk16_half(const float* sc_s, int t, int part, unsigned (&a)[32]) {
#pragma unroll
  for (int i = 0; i < 32; ++i) {
    const int nn = 4 * i + part;
    a[i] = (fkey(sc_s[t * 132 + nn]) & ~127u) | (unsigned)(127 - nn);
  }
  bitonic_sort_desc<32>(a);
  merge16_group4(a);
}
struct EpiQG {
  u16* Q; int m0, n0;
  __device__ __forceinline__ void pre(int, int, int) {}
  __device__ __forceinline__ void operator()(int r, int c, float v, int) const { Q[(size_t)(m0 + r) * 2048 + n0 + c] = f2bf(v); }
};
__device__ __forceinline__ void phase_q(const Params& p, int l, unsigned char* lds, u16* Qg) {
  const u16* A = (const u16*)(p.ws + WS_HB);
  const u16* B = (const u16*)(p.ws + WS_WQ) + (size_t)l * 2048 * DM;
  for (int j = blockIdx.x >> 3; ; j += gridDim.x >> 3) {
    int mb, nbk; if (!xcd_tile<16>(j, mb, nbk)) break;
    EpiQG e{Qg, mb * 128, nbk * 128};
    gemm_tile<128, 128, 64>(A, B, DM, mb * 128, nbk * 128, lds, e);
  }
}
__device__ __forceinline__ void phase_route(const Params& p, int l, unsigned char* lds, const u16* Qg) {
  const int tid = ltid(), lane = tid & 63, wave = tid >> 6, lr = lane & 15, lq = lane >> 4;
  u16* q_s = (u16*)lds;
  float* sc_s = (float*)(lds + 33792);
  u16* kb_s = (u16*)(lds + 33792);
  unsigned* key_s = (unsigned*)(lds + 68608);
  int* EIDX = (int*)(p.ws + WS_EIDX); float* GATE = (float*)(p.ws + WS_GATE);
  for (int it = blockIdx.x; it < (T_TOK / 64) * 8; it += gridDim.x) {
    const int mb = it >> 3, hd = it & 7;
    {
      u32x4 rq[8];
#pragma unroll
      for (int m = 0; m < 8; ++m) { const int i = tid + m * 256, r = i >> 5, c8 = i & 31; const u16* gp = Qg + (size_t)(mb * 64 + r) * 2048 + hd * 256 + c8 * 8; GLD_B128(rq[m], gp); }
      VM_WAIT0();
#pragma unroll
      for (int m = 0; m < 8; ++m) { const int i = tid + m * 256, r = i >> 5, c8 = i & 31; *(u32x4*)(q_s + r * 264 + c8 * 8) = rq[m]; }
    }
    __syncthreads();
    const int t = tid >> 2, part = tid & 3;
#pragma unroll 1
    for (int half = 0; half < 2; ++half) {
      const u16* Kb = (const u16*)(p.ws + (half ? WS_K2 : WS_K1)) + (size_t)l * 128 * 128;
      __syncthreads();
      {
        u32x4 rk[8];
#pragma unroll
        for (int m = 0; m < 8; ++m) { const int i = tid + m * 256, n = i >> 4, c8 = i & 15; rk[m] = *(const u32x4*)(Kb + (size_t)n * 128 + c8 * 8); }
#pragma unroll
        for (int m = 0; m < 8; ++m) { const int i = tid + m * 256, n = i >> 4, c8 = i & 15; *(u32x4*)(kb_s + n * 136 + c8 * 8) = rk[m]; }
      }
      __syncthreads();
      f32x4 sa[8];
#pragma unroll
      for (int j = 0; j < 8; ++j) sa[j] = (f32x4){0.f, 0.f, 0.f, 0.f};
#pragma unroll
      for (int ks = 0; ks < 4; ++ks) {
        const bf16x8 a = *(const bf16x8*)(q_s + (wave * 16 + lr) * 264 + half * 128 + ks * 32 + lq * 8);
#pragma unroll
        for (int j = 0; j < 8; ++j) {
          const bf16x8 bb = *(const bf16x8*)(kb_s + (j * 16 + lr) * 136 + ks * 32 + lq * 8);
          sa[j] = __builtin_amdgcn_mfma_f32_16x16x32_bf16(a, bb, sa[j], 0, 0, 0);
        }
      }
      __syncthreads();
#pragma unroll
      for (int j = 0; j < 8; ++j)
#pragma unroll
        for (int r = 0; r < 4; ++r) sc_s[(wave * 16 + lq * 4 + r) * 132 + j * 16 + lr] = sa[j][r];
      __syncthreads();
      unsigned a[32];
      topk16_half(sc_s, t, part, a);
      if (part == 0) {
#pragma unroll
        for (int w = 0; w < 4; ++w) *(uint4*)(key_s + t * 32 + half * 16 + 4 * w) = make_uint4(a[4 * w], a[4 * w + 1], a[4 * w + 2], a[4 * w + 3]);
      }
    }
    __syncthreads();
    {
      const unsigned* k1p = key_s + t * 32; const unsigned* k2p = k1p + 16;
      float v2[16];
#pragma unroll
      for (int j = 0; j < 16; ++j) v2[j] = funkey(k2p[j] & ~127u);
      unsigned c[32];
#pragma unroll
      for (int i = 0; i < 32; ++i) c[i] = 0u;
      {
        const int i0 = part; const float v1 = funkey(k1p[i0] & ~127u); const int nj = 16 / (i0 + 1);
#pragma unroll
        for (int j = 0; j < 16; ++j) c[j] = (j < nj) ? ((fkey(v1 + v2[j]) & ~255u) | (unsigned)(255 - (i0 * 16 + j))) : 0u;
      }
      {
        const int i1 = part + 4; const float v1 = funkey(k1p[i1] & ~127u); const int nj = 16 / (i1 + 1);
#pragma unroll
        for (int j = 0; j < 3; ++j) c[16 + j] = (j < nj) ? ((fkey(v1 + v2[j]) & ~255u) | (unsigned)(255 - (i1 * 16 + j))) : 0u;
      }
      { const int i2 = part + 8;  const float v1 = funkey(k1p[i2] & ~127u); c[19] = (fkey(v1 + v2[0]) & ~255u) | (unsigned)(255 - (i2 * 16)); }
      { const int i3 = part + 12; const float v1 = funkey(k1p[i3] & ~127u); c[20] = (fkey(v1 + v2[0]) & ~255u) | (unsigned)(255 - (i3 * 16)); }
      bitonic_sort_desc<32>(c);
      merge16_group4(c);
      const float m = funkey(c[0] & ~255u);
      float ex[16]; float ssum = 0.f;
#pragma unroll
      for (int r = 0; r < 16; ++r) { ex[r] = __expf(funkey(c[r] & ~255u) - m); ssum += ex[r]; }
      const float inv = 1.f / ssum;
      int ei4[4]; float g4[4];
#pragma unroll
      for (int w = 0; w < 4; ++w) {
        const unsigned ck = (part == 0) ? c[w] : (part == 1) ? c[4 + w] : (part == 2) ? c[8 + w] : c[12 + w];
        const float ev = (part == 0) ? ex[w] : (part == 1) ? ex[4 + w] : (part == 2) ? ex[8 + w] : ex[12 + w];
        const unsigned pos = 255u - (ck & 255u);
        const int i1 = 127 - (int)(k1p[pos >> 4] & 127u), i2 = 127 - (int)(k2p[pos & 15] & 127u);
        ei4[w] = i1 * 128 + i2; g4[w] = ev * inv;
      }
      const size_t base = ((size_t)hd * T_TOK + mb * 64 + t) * 16 + part * 4;
      *(int4*)(EIDX + base) = make_int4(ei4[0], ei4[1], ei4[2], ei4[3]);
      *(float4*)(GATE + base) = make_float4(g4[0], g4[1], g4[2], g4[3]);
    }
    __syncthreads();
  }
}

typedef float f32x2 __attribute__((ext_vector_type(2)));
__device__ __forceinline__ void ln_row_c(float (&y)[16], const float* __restrict__ g, const float* __restrict__ b, int lane,
                                         float* __restrict__ outf, u16* __restrict__ outb) {
  float s = 0.f;
#pragma unroll
  for (int i = 0; i < 16; ++i) s += y[i];
  const float mean = wave_sum(s) * (1.f / 1024.f);
  float q = 0.f;
#pragma unroll
  for (int i = 0; i < 16; ++i) { y[i] -= mean; q += y[i] * y[i]; }
  const float rstd = rsqrtf(wave_sum(q) * (1.f / 1024.f) + LN_EPS);
  const int c0 = lane * 16;
  unsigned pk[8];
#pragma unroll
  for (int q4 = 0; q4 < 4; ++q4) {
    const float4 gg = *(const float4*)(g + c0 + q4 * 4), bb = *(const float4*)(b + c0 + q4 * 4);
    float4 o;
    o.x = y[q4 * 4 + 0] * rstd * gg.x + bb.x; o.y = y[q4 * 4 + 1] * rstd * gg.y + bb.y;
    o.z = y[q4 * 4 + 2] * rstd * gg.z + bb.z; o.w = y[q4 * 4 + 3] * rstd * gg.w + bb.w;
    *(float4*)(outf + c0 + q4 * 4) = o;
    pk[q4 * 2] = cvtpk(o.x, o.y); pk[q4 * 2 + 1] = cvtpk(o.z, o.w);
  }
  if (outb) {
    *(uint4*)(outb + c0) = make_uint4(pk[0], pk[1], pk[2], pk[3]);
    *(uint4*)(outb + c0 + 8) = make_uint4(pk[4], pk[5], pk[6], pk[7]);
  }
}
#define EXP_LOAD(buf, tab, g_) do { const int ev_ = ((g_) < 8) ? e0 : e1; \
  _Pragma("unroll") for (int e_ = 0; e_ < 8; ++e_) { const int idx_ = __builtin_amdgcn_readlane(ev_, ((g_) & 7) * 8 + e_); \
    buf[e_] = *(const uint4*)((tab) + (size_t)idx_ * DM + lane * 16); } } while (0)
__device__ __forceinline__ float dot16_fp8(const uint4& w, const f32x2 (&x2)[8]) {
  f32x2 acc = {0.f, 0.f};
  acc += __builtin_amdgcn_cvt_pk_f32_fp8((int)w.x, false) * x2[0]; acc += __builtin_amdgcn_cvt_pk_f32_fp8((int)w.x, true) * x2[1];
  acc += __builtin_amdgcn_cvt_pk_f32_fp8((int)w.y, false) * x2[2]; acc += __builtin_amdgcn_cvt_pk_f32_fp8((int)w.y, true) * x2[3];
  acc += __builtin_amdgcn_cvt_pk_f32_fp8((int)w.z, false) * x2[4]; acc += __builtin_amdgcn_cvt_pk_f32_fp8((int)w.z, true) * x2[5];
  acc += __builtin_amdgcn_cvt_pk_f32_fp8((int)w.w, false) * x2[6]; acc += __builtin_amdgcn_cvt_pk_f32_fp8((int)w.w, true) * x2[7];
  return acc[0] + acc[1];
}
__device__ __forceinline__ void axpy16_fp8(const uint4& w, float c, f32x2 (&o2)[8]) {
  const f32x2 cc = {c, c};
  o2[0] += cc * __builtin_amdgcn_cvt_pk_f32_fp8((int)w.x, false); o2[1] += cc * __builtin_amdgcn_cvt_pk_f32_fp8((int)w.x, true);
  o2[2] += cc * __builtin_amdgcn_cvt_pk_f32_fp8((int)w.y, false); o2[3] += cc * __builtin_amdgcn_cvt_pk_f32_fp8((int)w.y, true);
  o2[4] += cc * __builtin_amdgcn_cvt_pk_f32_fp8((int)w.z, false); o2[5] += cc * __builtin_amdgcn_cvt_pk_f32_fp8((int)w.z, true);
  o2[6] += cc * __builtin_amdgcn_cvt_pk_f32_fp8((int)w.w, false); o2[7] += cc * __builtin_amdgcn_cvt_pk_f32_fp8((int)w.w, true);
}
__device__ __forceinline__ void phase_expert(const Params& p, int l, unsigned char* lds, bool last) {
  const int tid = ltid(), lane = tid & 63, wave = tid >> 6;
  float* c_w = (float*)lds + wave * 2048;
  int* sw = (int*)(lds + 32768) + wave * 384;
  const unsigned char* U8 = p.ws + WS_UB + (size_t)l * NEXP * DM;
  const unsigned char* V8 = p.ws + WS_VB + (size_t)l * NEXP * DM;
  const unsigned* SUV = (const unsigned*)(p.ws + WS_SU) + (size_t)l * NEXP;
  const int* EIDX = (const int*)(p.ws + WS_EIDX); const float* GATE = (const float*)(p.ws + WS_GATE);
  int* EP = (int*)(p.ws + WS_QG);
  float* GP = (float*)(p.ws + WS_QG) + (size_t)T_TOK * 128;
  float* UP = (float*)(p.ws + WS_QG) + (size_t)2 * T_TOK * 128;
  float* H = (float*)(p.ws + WS_H); u16* HB = (u16*)(p.ws + WS_HB);
  const int eperm = ((lane & 1) << 2) | (((lane >> 1) & 1) << 1) | ((lane >> 2) & 1);
  const int tstep = gridDim.x * 4;
#define LOAD_X2(t_) do { const float* xr = H + (size_t)(t_) * DM + lane * 16; \
    _Pragma("unroll") for (int q4 = 0; q4 < 4; ++q4) { const float4 a = *(const float4*)(xr + q4 * 4); x2[q4 * 2] = (f32x2){a.x, a.y}; x2[q4 * 2 + 1] = (f32x2){a.z, a.w}; } } while (0)
#define LOAD_X2B(t_) do { const u16* xr = HB + (size_t)(t_) * DM + lane * 16; \
    const u32x4 w0 = *(const u32x4*)(xr), w1 = *(const u32x4*)(xr + 8); \
    x2[0] = (f32x2){bflo(w0.x), bfhi(w0.x)}; x2[1] = (f32x2){bflo(w0.y), bfhi(w0.y)}; x2[2] = (f32x2){bflo(w0.z), bfhi(w0.z)}; x2[3] = (f32x2){bflo(w0.w), bfhi(w0.w)}; \
    x2[4] = (f32x2){bflo(w1.x), bfhi(w1.x)}; x2[5] = (f32x2){bflo(w1.y), bfhi(w1.y)}; x2[6] = (f32x2){bflo(w1.z), bfhi(w1.z)}; x2[7] = (f32x2){bflo(w1.w), bfhi(w1.w)}; } while (0)
#define U_PART(gb, NP) do { uint4 ba[8], bb[8]; \
    EXP_LOAD(ba, U8, (gb)); \
    _Pragma("unroll 1") for (int gp = 0; gp < (NP); ++gp) { \
      _Pragma("unroll") for (int hh = 0; hh < 2; ++hh) { \
        const int grp = (gb) + gp * 2 + hh; \
        if (hh == 0) { EXP_LOAD(bb, U8, grp + 1); } else if (gp < (NP) - 1) { EXP_LOAD(ba, U8, grp + 1); } \
        float pd[8]; \
        _Pragma("unroll") for (int e = 0; e < 8; ++e) pd[e] = dot16_fp8(hh == 0 ? ba[e] : bb[e], x2); \
        float q4v[4], r2[2], s1; \
        const bool b0 = lane & 1, b1 = (lane >> 1) & 1, b2 = (lane >> 2) & 1; \
        _Pragma("unroll") for (int i = 0; i < 4; ++i) { const float keep = b0 ? pd[i + 4] : pd[i], send = b0 ? pd[i] : pd[i + 4]; q4v[i] = keep + __shfl_xor(send, 1); } \
        _Pragma("unroll") for (int i = 0; i < 2; ++i) { const float keep = b1 ? q4v[i + 2] : q4v[i], send = b1 ? q4v[i] : q4v[i + 2]; r2[i] = keep + __shfl_xor(send, 2); } \
        { const float keep = b2 ? r2[1] : r2[0], send = b2 ? r2[0] : r2[1]; s1 = keep + __shfl_xor(send, 4); } \
        s1 += __shfl_xor(s1, 8); s1 += __shfl_xor(s1, 16); s1 += __shfl_xor(s1, 32); \
        const float gate = __shfl((grp < 8) ? gv0 : gv1, (grp & 7) * 8 + eperm); \
        const float usc = __shfl((grp < 8) ? su0 : su1, (grp & 7) * 8 + eperm); \
        const float cval = gelu_f(s1 * usc) * gate; \
        if (lane < 8) c_s[grp * 8 + eperm] = cval; \
      } } } while (0)
#define V_HALF(gb) do { uint4 ba[8], bb[8]; \
    EXP_LOAD(ba, V8, (gb)); \
    _Pragma("unroll 1") for (int gp = 0; gp < 4; ++gp) { \
      _Pragma("unroll") for (int hh = 0; hh < 2; ++hh) { \
        const int grp = (gb) + gp * 2 + hh; \
        if (hh == 0) { EXP_LOAD(bb, V8, grp + 1); } else if (gp < 3) { EXP_LOAD(ba, V8, grp + 1); } \
        _Pragma("unroll") for (int e = 0; e < 8; ++e) axpy16_fp8(hh == 0 ? ba[e] : bb[e], c_s[grp * 8 + e], o2); \
      } } } while (0)
  for (int tbase = blockIdx.x * 4 + wave; tbase < T_TOK; tbase += tstep * 16) {
    int slot = 0;
    for (int t = tbase; t < T_TOK && slot < 16; t += tstep, ++slot) {
      float* c_s = c_w + slot * 128;
      f32x2 x2[8];
      LOAD_X2B(t);
      const size_t eo0 = ((size_t)(lane >> 4) * T_TOK + t) * 16 + (lane & 15), eo1 = eo0 + (size_t)4 * T_TOK * 16;
      const int r0 = EIDX[eo0], r1 = EIDX[eo1];
      const unsigned sw0 = SUV[r0], sw1 = SUV[r1];
      const float rg0 = GATE[eo0] * bfhi(sw0), rg1 = GATE[eo1] * bfhi(sw1), ru0 = bflo(sw0), ru1 = bflo(sw1);
      int e0, e1 = 0; float gv0, gv1 = 0.f, su0, su1 = 0.f;
      {
        const int q0 = r0 >> 12, q1 = r1 >> 12;
        const unsigned long long lt = (1ull << lane) - 1ull;
        int base = 0, pos0 = 0, pos1 = 0;
#pragma unroll
        for (int q = 0; q < 4; ++q) {
          const unsigned long long m0 = __ballot(q0 == q), m1 = __ballot(q1 == q);
          const int n0 = __popcll(m0), n1 = __popcll(m1);
          if (q0 == q) pos0 = base + __popcll(m0 & lt);
          if (q1 == q) pos1 = base + n0 + __popcll(m1 & lt);
          base += n0 + n1;
        }
        sw[pos0] = r0; sw[pos1] = r1;
        sw[128 + pos0] = __float_as_int(rg0); sw[128 + pos1] = __float_as_int(rg1);
        sw[256 + pos0] = __float_as_int(ru0); sw[256 + pos1] = __float_as_int(ru1);
        __builtin_amdgcn_fence(__ATOMIC_RELEASE, "workgroup");
        __builtin_amdgcn_wave_barrier();
        __builtin_amdgcn_fence(__ATOMIC_ACQUIRE, "workgroup");
        e0 = sw[lane]; const int e1p = sw[64 + lane];
        gv0 = __int_as_float(sw[128 + lane]); const float gv1p = __int_as_float(sw[192 + lane]);
        su0 = __int_as_float(sw[256 + lane]); const float su1p = __int_as_float(sw[320 + lane]);
        __builtin_amdgcn_fence(__ATOMIC_RELEASE, "workgroup");
        __builtin_amdgcn_wave_barrier();
        EP[(size_t)t * 128 + lane] = e0; EP[(size_t)t * 128 + 64 + lane] = e1p;
        GP[(size_t)t * 128 + lane] = gv0; GP[(size_t)t * 128 + 64 + lane] = gv1p;
        UP[(size_t)t * 128 + lane] = su0; UP[(size_t)t * 128 + 64 + lane] = su1p;
      }
      U_PART(0, 2);
    }
#pragma unroll 1
    for (int qtr = 1; qtr < 4; ++qtr) {
      slot = 0;
      for (int t = tbase; t < T_TOK && slot < 16; t += tstep, ++slot) {
        float* c_s = c_w + slot * 128;
        f32x2 x2[8];
        LOAD_X2B(t);
        const int hi = (qtr >= 2) ? 64 : 0;
        const int ev = EP[(size_t)t * 128 + hi + lane];
        const float gvv = GP[(size_t)t * 128 + hi + lane], suv = UP[(size_t)t * 128 + hi + lane];
        const int e0 = ev, e1 = ev; const float gv0 = gvv, gv1 = gvv, su0 = suv, su1 = suv;
        U_PART(qtr * 4, 2);
      }
    }
    __builtin_amdgcn_fence(__ATOMIC_RELEASE, "workgroup");
    __builtin_amdgcn_wave_barrier();
    __builtin_amdgcn_fence(__ATOMIC_ACQUIRE, "workgroup");
    slot = 0;
    for (int t = tbase; t < T_TOK && slot < 16; t += tstep, ++slot) {
      const float* c_s = c_w + slot * 128;
      f32x2 x2[8];
      LOAD_X2(t);
      const int e0 = EP[(size_t)t * 128 + lane], e1 = EP[(size_t)t * 128 + 64 + lane];
      f32x2 o2[8];
#pragma unroll
      for (int i = 0; i < 8; ++i) o2[i] = (f32x2){0.f, 0.f};
      V_HALF(0);
      V_HALF(8);
      float o[16];
#pragma unroll
      for (int i = 0; i < 8; ++i) { o[2 * i] = o2[i][0] + ALPHA * x2[i][0]; o[2 * i + 1] = o2[i][1] + ALPHA * x2[i][1]; }
      if (last) ln_row_c(o, p.in[I_L2G] + (size_t)l * DM, p.in[I_L2B] + (size_t)l * DM, lane, p.out + (size_t)t * DM, (u16*)nullptr);
      else ln_row_c(o, p.in[I_L2G] + (size_t)l * DM, p.in[I_L2B] + (size_t)l * DM, lane, H + (size_t)t * DM, HB + (size_t)t * DM);
    }
    __builtin_amdgcn_fence(__ATOMIC_RELEASE, "workgroup");
    __builtin_amdgcn_wave_barrier();
  }
#undef LOAD_X2
#undef LOAD_X2B
#undef U_PART
#undef V_HALF
}

#define XB_TMO      128
#define XB_XCNT(j)  (256  + 64 * (j))
#define XB_XSUB(j)  (1280 + 64 * (j))
#define XB_XGEN(j)  (2304 + 64 * (j))
#define XB_TOP      3328
#define XB_TOPGEN   3392
#define XB_SPIN_CAP (1u << 20)
#define LAS __attribute__((address_space(3)))
__device__ __forceinline__ unsigned xb_ld(unsigned* p)              { return __hip_atomic_load(p, __ATOMIC_RELAXED, __HIP_MEMORY_SCOPE_AGENT); }
__device__ __forceinline__ unsigned xb_add(unsigned* p, unsigned v) { return __hip_atomic_fetch_add(p, v, __ATOMIC_RELAXED, __HIP_MEMORY_SCOPE_AGENT); }
__device__ __forceinline__ unsigned xb_xcc_id() { return (unsigned)__builtin_amdgcn_s_getreg((3 << 11) | 20) & 0xFu; }
#define XB_SPIN(cond, bar) do { unsigned _sp = 0; while (cond) { __builtin_amdgcn_s_sleep(1); \
    if ((++_sp & 255u) == 0u) { if (xb_ld(&(bar)[XB_TMO])) break; if (_sp > XB_SPIN_CAP) { atomicAdd(&(bar)[XB_TMO], 1u); break; } } } } while (0)
struct XcdBarrier { unsigned* bar; unsigned x; volatile LAS unsigned* st; };
__device__ __forceinline__ XcdBarrier xcd_barrier_post(unsigned* bar, volatile LAS unsigned* st) {
  XcdBarrier b; b.bar = bar; b.x = xb_xcc_id(); b.st = st;
  if (threadIdx.x == 0) (void)xb_add(&bar[XB_XCNT(b.x)], 1u);
  return b;
}
__device__ __forceinline__ void xcd_barrier_complete(unsigned* bar, unsigned x, unsigned& nloc, unsigned& nx) {
  const unsigned G = gridDim.x;
  unsigned sum, cnt, mine, sp = 0u;
  for (;;) {
    sum = 0u; cnt = 0u; mine = 0u;
#pragma unroll
    for (unsigned j = 0; j < 16; ++j) { const unsigned c = xb_ld(&bar[XB_XCNT(j)]); sum += c; cnt += (c > 0u) ? 1u : 0u; mine = (j == x) ? c : mine; }
    if (sum == G) break;
    __builtin_amdgcn_s_sleep(1);
    if ((++sp & 255u) == 0u) { if (xb_ld(&bar[XB_TMO])) break; if (sp > XB_SPIN_CAP) { atomicAdd(&bar[XB_TMO], 1u); break; } }
  }
  nloc = mine > 0u ? mine : 1u; nx = cnt > 0u ? cnt : 1u;
}
__device__ __forceinline__ void xcd_barrier(const XcdBarrier& b) {
  asm volatile("s_waitcnt vmcnt(0)" ::: "memory");
  __syncthreads();
  if (threadIdx.x == 0) {
    unsigned* bar = b.bar;
    __builtin_amdgcn_s_waitcnt(0);
    unsigned nloc = b.st[0], nx = b.st[1];
    if (nloc == 0u) { xcd_barrier_complete(bar, b.x, nloc, nx); b.st[0] = nloc; b.st[1] = nx; }
    const unsigned old = xb_add(&bar[XB_XSUB(b.x)], 1u);
    const unsigned gen = old / nloc;
    if (old + 1u == (gen + 1u) * nloc) {
      __builtin_amdgcn_fence(__ATOMIC_RELEASE, "agent");
      asm volatile("s_waitcnt vmcnt(0)" ::: "memory");
      const unsigned og = xb_add(&bar[XB_TOP], 1u);
      const unsigned tg = og / nx;
      if (og + 1u == (tg + 1u) * nx) xb_add(&bar[XB_TOPGEN], 1u);
      else XB_SPIN(xb_ld(&bar[XB_TOPGEN]) == tg, bar);
      __builtin_amdgcn_fence(__ATOMIC_ACQUIRE, "agent");
      xb_add(&bar[XB_XGEN(b.x)], 1u);
      asm volatile("s_waitcnt vmcnt(0)" ::: "memory");
    } else {
      XB_SPIN(xb_ld(&bar[XB_XGEN(b.x)]) == gen, bar);
      __builtin_amdgcn_fence(__ATOMIC_ACQUIRE, "agent");
      asm volatile("s_waitcnt vmcnt(0)" ::: "memory");
    }
  }
  __syncthreads();
}
__global__ void __launch_bounds__(256, 2) fwd_mega(Params p) {
  extern __shared__ __attribute__((aligned(16))) unsigned char lds[];
  cg::grid_group grid = cg::this_grid();
  if (p.ph_lo < 0) grid.sync();
  volatile LAS unsigned* xb_st = (volatile LAS unsigned*)(LAS unsigned char*)(lds + LDS_BYTES - 16);
  if (threadIdx.x == 0) { xb_st[0] = 0u; xb_st[1] = 0u; }
  __syncthreads();
  const XcdBarrier xbar = xcd_barrier_post((unsigned*)(p.ws + WS_XBAR), xb_st);
  for (int ph = p.ph_lo; ph < p.ph_hi; ++ph) {
    if (ph == 0) {
      phase_prologue(p, lds);
    } else {
      const int l = (ph - 1) / 9, sub = (ph - 1) % 9;
      if (sub == 0) { phase_inproj(p, l, lds); }
      else if (sub == 1) {
        for (int it = blockIdx.x; it < 1536; it += gridDim.x) { if (it < 512) sgu_item(p, l, it, lds); else gla_passA_item(p, l, it - 512, lds); }
      }
      else if (sub == 2) { for (int it = blockIdx.x; it < 1024; it += gridDim.x) scan_item(p, it); }
      else if (sub == 3) { for (int it = blockIdx.x; it < 1024; it += gridDim.x) gla_passC_item(p, l, it, lds); }
      else if (sub == 4) { phase_outproj(p, l, lds); }
      else if (sub == 5) { phase_ln1(p, l); }
      else if (sub == 6) { phase_q(p, l, lds, (u16*)(p.ws + WS_QG)); }
      else if (sub == 7) { phase_route(p, l, lds, (const u16*)(p.ws + WS_QG)); }
      else { phase_expert(p, l, lds, l == NL - 1); }
    }
    if (ph + 1 < p.ph_hi) xcd_barrier(xbar);
  }
}

extern "C" void kernel_launch(void* const* d_in, const int* in_sizes, int n_in,
                              void* d_out, int out_size, void* d_ws, size_t ws_size,
                              hipStream_t stream) {
  static int grid_blocks = 0;
  if (!grid_blocks) {
    if (n_in != 21 || out_size != T_TOK * DM || ws_size < WS_END) {
      fprintf(stderr, "kernel_launch: unexpected shapes n_in=%d out=%d ws=%zu (need %zu)\n", n_in, out_size, ws_size, (size_t)WS_END);
      grid_blocks = -1; return;
    }
    int dev = 0, cus = 0, per_cu = 0;
    (void)hipGetDevice(&dev);
    (void)hipDeviceGetAttribute(&cus, hipDeviceAttributeMultiprocessorCount, dev);
    (void)hipFuncSetAttribute((const void*)fwd_mega, hipFuncAttributeMaxDynamicSharedMemorySize, LDS_BYTES);
    (void)hipOccupancyMaxActiveBlocksPerMultiprocessor(&per_cu, (const void*)fwd_mega, 256, LDS_BYTES);
    if (per_cu < 1) per_cu = 1;
    if (per_cu > 2) per_cu = 2;
    grid_blocks = cus * per_cu;
    fprintf(stderr, "kernel_launch: grid %d (cus %d x %d)\n", grid_blocks, cus, per_cu);
  }
  if (grid_blocks < 0) return;
  Params p{};
  for (int i = 0; i < 21; ++i) p.in[i] = (const float*)d_in[i];
  p.out = (float*)d_out; p.ws = (unsigned char*)d_ws; p.ph_lo = 0; p.ph_hi = NPHASE;
  (void)hipMemsetAsync((unsigned char*)d_ws + WS_BAR, 0, 16384, stream);
  void* args[] = {&p};
  hipError_t e = hipLaunchCooperativeKernel((void*)fwd_mega, dim3(grid_blocks), dim3(256), args, LDS_BYTES, stream);
  if (e != hipSuccess) fprintf(stderr, "cooperative launch failed: %s (grid %d)\n", hipGetErrorString(e), grid_blocks);
}
```

```cpp
#include <hip/hip_runtime.h>
#include <hip/hip_cooperative_groups.h>
#include <cstdio>
namespace cg = cooperative_groups;

typedef unsigned short u16;
using bf16x8 = __attribute__((ext_vector_type(8))) short;
using f32x4  = __attribute__((ext_vector_type(4))) float;
using u32x4  = __attribute__((ext_vector_type(4))) unsigned;
typedef __bf16 bf16x2_t __attribute__((ext_vector_type(2)));

constexpr int T_TOK = 16384;
constexpr int DM = 1024;
constexpr int INC = 2576;
constexpr int INCP = 2688;
constexpr int PLD = 2688;
constexpr int NL = 2;
constexpr int NEXP = 16384;
constexpr float LN_EPS = 1e-5f;
constexpr float ALPHA = 1.4142135623730951f;
constexpr int C_Q = 0, C_K = 256, C_V = 512, C_R = 1024, C_A = 1536, C_SU = 1552, C_SV = 2064;

constexpr size_t AL(size_t x) { return (x + 255) & ~(size_t)255; }
constexpr size_t WS_WIN  = 0;
constexpr size_t WS_WOUT = WS_WIN  + AL((size_t)NL * INCP * DM * 2);
constexpr size_t WS_WQ   = WS_WOUT + AL((size_t)NL * DM * DM * 2);
constexpr size_t WS_K1   = WS_WQ   + AL((size_t)NL * 2048 * DM * 2);
constexpr size_t WS_K2   = WS_K1   + AL((size_t)NL * 128 * 128 * 2);
constexpr size_t WS_SGUW = WS_K2   + AL((size_t)NL * 128 * 128 * 2);
constexpr size_t WS_UB   = WS_SGUW + AL((size_t)NL * 4 * 128 * 128 * 2);
constexpr size_t WS_VB   = WS_UB   + AL((size_t)NL * NEXP * DM * 2);
constexpr size_t WS_H    = WS_VB   + AL((size_t)NL * NEXP * DM * 2);
constexpr size_t WS_HB   = WS_H    + AL((size_t)T_TOK * DM * 4);
constexpr size_t WS_P    = WS_HB   + AL((size_t)T_TOK * DM * 2);
constexpr size_t WS_MC   = WS_P    + AL((size_t)T_TOK * PLD * 2);
constexpr size_t WS_KC   = WS_MC   + AL((size_t)T_TOK * DM * 2);
constexpr size_t WS_ST   = WS_KC   + AL((size_t)32 * 32 * 64 * 128 * 4);
constexpr size_t WS_DEC  = WS_ST   + AL((size_t)32 * 32 * 64 * 128 * 2);
constexpr size_t WS_EIDX = WS_DEC  + AL((size_t)32 * 32 * 64 * 4);
constexpr size_t WS_GATE = WS_EIDX + AL((size_t)T_TOK * 128 * 4);
constexpr size_t WS_QG   = WS_GATE + AL((size_t)T_TOK * 128 * 4);
constexpr size_t WS_BAR  = WS_QG + AL((size_t)T_TOK * 2048 * 2);
constexpr size_t WS_XBAR = WS_BAR + 256;
constexpr size_t WS_SU   = WS_XBAR + 16384 - 256;
constexpr size_t WS_SV   = WS_SU + (size_t)NL * NEXP * 4;
constexpr size_t WS_END  = WS_SV + (size_t)NL * NEXP * 4;

constexpr size_t WS_QDKD = WS_UB + ((size_t)40 << 20);
constexpr int LDS_BYTES = 77824;
constexpr int NPHASE = 1 + NL * 9;

struct Params {
  const float* in[21];
  float* out; unsigned char* ws; int ph_lo, ph_hi;
};
enum { I_X = 0, I_LNIG, I_LNIB, I_WIN, I_WGU, I_BG, I_GNG, I_SLG, I_SLB, I_SW, I_SB, I_WOUT, I_L1G, I_L1B, I_WQ, I_K1, I_K2, I_U, I_V, I_L2G, I_L2B };

__device__ __forceinline__ int ltid() { int t = threadIdx.x; asm volatile("" : "+v"(t)); return t; }
__device__ __forceinline__ unsigned cvtpk(float lo, float hi) { bf16x2_t v; v[0] = (__bf16)lo; v[1] = (__bf16)hi; return __builtin_bit_cast(unsigned, v); }
__device__ __forceinline__ u16 f2bf(float f) { return __builtin_bit_cast(u16, (__bf16)f); }
__device__ __forceinline__ float bf2f(u16 h) { return __uint_as_float(((unsigned)h) << 16); }
__device__ __forceinline__ float bflo(unsigned w) { return __uint_as_float(w << 16); }
__device__ __forceinline__ float bfhi(unsigned w) { return __uint_as_float(w & 0xffff0000u); }
__device__ __forceinline__ float gelu_f(float x) { return 0.5f * x * (1.f + erff(x * 0.70710678118654752f)); }
__device__ __forceinline__ float logsig(float x) { return fminf(x, 0.f) - log1pf(__expf(-fabsf(x))); }
__device__ __forceinline__ float wave_sum(float v) {
#pragma unroll
  for (int o = 32; o; o >>= 1) v += __shfl_xor(v, o);
  return v;
}
__device__ __forceinline__ float dot2(unsigned w, unsigned x, float acc) {
  return __builtin_amdgcn_fdot2_f32_bf16(__builtin_bit_cast(bf16x2_t, w), __builtin_bit_cast(bf16x2_t, x), acc, false);
}
__device__ __forceinline__ unsigned fkey(float f) { unsigned u = __float_as_uint(f); return u ^ ((u >> 31) ? 0xffffffffu : 0x80000000u); }
__device__ __forceinline__ float funkey(unsigned k) { unsigned u = k ^ ((k >> 31) ? 0x80000000u : 0xffffffffu); return __uint_as_float(u); }

#define GLD_B128(dst, ptr) dst = *(const u32x4*)(ptr)
#define GLD_B32(dst, ptr)  dst = *(const unsigned*)(ptr)
#define VM_WAIT0() asm volatile("s_waitcnt vmcnt(0)" ::: "memory")
__device__ __forceinline__ void unpack8(const u32x4& w, float (&f)[8]) {
  f[0] = bflo(w.x); f[1] = bfhi(w.x); f[2] = bflo(w.y); f[3] = bfhi(w.y); f[4] = bflo(w.z); f[5] = bfhi(w.z); f[6] = bflo(w.w); f[7] = bfhi(w.w);
}
__device__ __forceinline__ void ln_row(float (&y)[16], const float* __restrict__ g, const float* __restrict__ b, int lane,
                                       float* __restrict__ outf, u16* __restrict__ outb) {
  float s = 0.f;
#pragma unroll
  for (int i = 0; i < 16; ++i) s += y[i];
  const float mean = wave_sum(s) * (1.f / 1024.f);
  float q = 0.f;
#pragma unroll
  for (int i = 0; i < 16; ++i) { y[i] -= mean; q += y[i] * y[i]; }
  const float rstd = rsqrtf(wave_sum(q) * (1.f / 1024.f) + LN_EPS);
#pragma unroll
  for (int hseg = 0; hseg < 2; ++hseg) {
    const int c0 = hseg * 512 + lane * 8;
    const float4 g0 = *(const float4*)(g + c0), g1 = *(const float4*)(g + c0 + 4);
    const float4 b0 = *(const float4*)(b + c0), b1 = *(const float4*)(b + c0 + 4);
    float4 o0, o1;
    o0.x = y[hseg * 8 + 0] * rstd * g0.x + b0.x; o0.y = y[hseg * 8 + 1] * rstd * g0.y + b0.y;
    o0.z = y[hseg * 8 + 2] * rstd * g0.z + b0.z; o0.w = y[hseg * 8 + 3] * rstd * g0.w + b0.w;
    o1.x = y[hseg * 8 + 4] * rstd * g1.x + b1.x; o1.y = y[hseg * 8 + 5] * rstd * g1.y + b1.y;
    o1.z = y[hseg * 8 + 6] * rstd * g1.z + b1.z; o1.w = y[hseg * 8 + 7] * rstd * g1.w + b1.w;
    *(float4*)(outf + c0) = o0; *(float4*)(outf + c0 + 4) = o1;
    if (outb) {
      uint4 w; w.x = cvtpk(o0.x, o0.y); w.y = cvtpk(o0.z, o0.w); w.z = cvtpk(o1.x, o1.y); w.w = cvtpk(o1.z, o1.w);
      *(uint4*)(outb + c0) = w;
    }
  }
}
__device__ __forceinline__ void load_row16(const float* __restrict__ src, int lane, float (&y)[16]) {
#pragma unroll
  for (int hseg = 0; hseg < 2; ++hseg) {
    const float4 a = *(const float4*)(src + hseg * 512 + lane * 8), b = *(const float4*)(src + hseg * 512 + lane * 8 + 4);
    y[hseg * 8 + 0] = a.x; y[hseg * 8 + 1] = a.y; y[hseg * 8 + 2] = a.z; y[hseg * 8 + 3] = a.w;
    y[hseg * 8 + 4] = b.x; y[hseg * 8 + 5] = b.y; y[hseg * 8 + 6] = b.z; y[hseg * 8 + 7] = b.w;
  }
}

template <int BM, int BN, int BK, class Epi>
__device__ __forceinline__ void gemm_tile(const u16* __restrict__ A, const u16* __restrict__ B, const int K,
                                          const int m0, const int n0, unsigned char* lds, Epi& epi) {
  constexpr int LDK = BK;
  constexpr int MT = BM / 32, NT = BN / 32;
  constexpr int CPR = BK / 8;
  constexpr int A_CH = BM * CPR / 256, B_CH = BN * CPR / 256;
  constexpr int STAGE = (BM + BN) * LDK * 2;
  const int tid = ltid(), lane = tid & 63, wave = tid >> 6;
  const int wm = wave >> 1, wn = wave & 1;
  const int lr = lane & 15, lq = lane >> 4;
  f32x4 acc[MT][NT];
#pragma unroll
  for (int i = 0; i < MT; ++i)
#pragma unroll
    for (int j = 0; j < NT; ++j) acc[i][j] = (f32x4){0.f, 0.f, 0.f, 0.f};
  u32x4 ra[2][A_CH], rb[2][B_CH];
  const int KT = K / BK;
#define GT_ISSUE(set, tile) do { const int k0_ = (((tile) < KT) ? (tile) : (KT - 1)) * BK; \
    _Pragma("unroll") for (int i = 0; i < A_CH; ++i) { const int c = tid + i * 256, row = c / CPR, kc = c % CPR; const u16* gp = A + (size_t)(m0 + row) * K + k0_ + kc * 8; \
      asm volatile("global_load_dwordx4 %0, %1, off" : "=&v"(ra[set][i]) : "v"(gp) : "memory"); } \
    _Pragma("unroll") for (int i = 0; i < B_CH; ++i) { const int c = tid + i * 256, row = c / CPR, kc = c % CPR; const u16* gp = B + (size_t)(n0 + row) * K + k0_ + kc * 8; \
      asm volatile("global_load_dwordx4 %0, %1, off" : "=&v"(rb[set][i]) : "v"(gp) : "memory"); } } while (0)
#define GT_STORE(set, stage) do { u16* dA = (u16*)(lds + (stage) * STAGE); u16* dB = dA + BM * LDK; \
    _Pragma("unroll") for (int i = 0; i < A_CH; ++i) { const int c = tid + i * 256, row = c / CPR, kc = c % CPR; *(u32x4*)(dA + row * LDK + ((kc ^ (row & 7)) * 8)) = ra[set][i]; } \
    _Pragma("unroll") for (int i = 0; i < B_CH; ++i) { const int c = tid + i * 256, row = c / CPR, kc = c % CPR; *(u32x4*)(dB + row * LDK + ((kc ^ (row & 7)) * 8)) = rb[set][i]; } } while (0)
#define GT_COMPUTE(stage) do { const u16* sA = (const u16*)(lds + (stage) * STAGE); const u16* sB = sA + BM * LDK; \
    _Pragma("unroll") for (int ks = 0; ks < BK / 32; ++ks) { bf16x8 af[MT], bfr[NT]; \
      _Pragma("unroll") for (int i = 0; i < MT; ++i) af[i] = *(const bf16x8*)(sA + (wm * (BM / 2) + i * 16 + lr) * LDK + (((ks * 4 + lq) ^ (lr & 7)) * 8)); \
      _Pragma("unroll") for (int j = 0; j < NT; ++j) bfr[j] = *(const bf16x8*)(sB + (wn * (BN / 2) + j * 16 + lr) * LDK + (((ks * 4 + lq) ^ (lr & 7)) * 8)); \
      _Pragma("unroll") for (int i = 0; i < MT; ++i) _Pragma("unroll") for (int j = 0; j < NT; ++j) acc[i][j] = __builtin_amdgcn_mfma_f32_16x16x32_bf16(af[i], bfr[j], acc[i][j], 0, 0, 0); } } while (0)
  GT_ISSUE(0, 0);
  asm volatile("s_waitcnt vmcnt(0)" ::: "memory");
  GT_STORE(0, 0);
  GT_ISSUE(1, 1);
  __syncthreads();
#pragma unroll 1
  for (int kt = 0; kt < KT; kt += 2) {
    const bool m2 = (kt + 2 < KT);
    if (m2) GT_ISSUE(0, kt + 2);
    __builtin_amdgcn_sched_barrier(0);
    GT_COMPUTE(0);
    __builtin_amdgcn_sched_barrier(0);
    if (m2) asm volatile("s_waitcnt vmcnt(8)" ::: "memory"); else asm volatile("s_waitcnt vmcnt(0)" ::: "memory");
    GT_STORE(1, 1);
    __syncthreads();
    if (m2) GT_ISSUE(1, kt + 3);
    __builtin_amdgcn_sched_barrier(0);
    GT_COMPUTE(1);
    __builtin_amdgcn_sched_barrier(0);
    if (m2) { asm volatile("s_waitcnt vmcnt(8)" ::: "memory"); GT_STORE(0, 0); }
    __syncthreads();
  }
#undef GT_ISSUE
#undef GT_STORE
#undef GT_COMPUTE
  {
    int slot = 0;
#pragma unroll
    for (int i = 0; i < MT; ++i)
#pragma unroll
      for (int j = 0; j < NT; ++j)
#pragma unroll
        for (int r = 0; r < 4; ++r) epi.pre(wm * (BM / 2) + i * 16 + lq * 4 + r, wn * (BN / 2) + j * 16 + lr, slot++);
    slot = 0;
#pragma unroll
    for (int i = 0; i < MT; ++i)
#pragma unroll
      for (int j = 0; j < NT; ++j)
#pragma unroll
        for (int r = 0; r < 4; ++r)
          epi(wm * (BM / 2) + i * 16 + lq * 4 + r, wn * (BN / 2) + j * 16 + lr, acc[i][j][r], slot++);
  }
}

__device__ __forceinline__ void transpose_tile(const float* __restrict__ src, int Ksrc, int Nsrc, u16* __restrict__ dst, int kt, int nt, float* tl) {
  const int tid = ltid();
  const int k0 = kt * 64, n0 = nt * 64;
  u32x4 r[4];
#pragma unroll
  for (int m = 0; m < 4; ++m) {
    const int i = tid + m * 256, kk = i >> 4, n4 = (i & 15) * 4;
    const int nn = (n0 + n4 < Nsrc) ? (n0 + n4) : 0;
    const float* gp = src + (size_t)(k0 + kk) * Nsrc + nn;
    GLD_B128(r[m], gp);
  }
  VM_WAIT0();
#pragma unroll
  for (int m = 0; m < 4; ++m) {
    const int i = tid + m * 256, kk = i >> 4, n4 = (i & 15) * 4;
    const bool ok = (n0 + n4 < Nsrc);
    tl[kk * 65 + n4 + 0] = ok ? __uint_as_float(r[m].x) : 0.f; tl[kk * 65 + n4 + 1] = ok ? __uint_as_float(r[m].y) : 0.f;
    tl[kk * 65 + n4 + 2] = ok ? __uint_as_float(r[m].z) : 0.f; tl[kk * 65 + n4 + 3] = ok ? __uint_as_float(r[m].w) : 0.f;
  }
  __syncthreads();
  for (int i = tid; i < 2048; i += 256) {
    const int nn = i >> 5, kp = i & 31;
    const unsigned w = cvtpk(tl[(2 * kp) * 65 + nn], tl[(2 * kp + 1) * 65 + nn]);
    *(unsigned*)(dst + (size_t)(n0 + nn) * Ksrc + k0 + 2 * kp) = w;
  }
  __syncthreads();
}
__device__ __forceinline__ void convert8(const float* __restrict__ src, u16* __restrict__ dst, size_t n8, size_t gtid, size_t gn) {
  for (size_t i = gtid; i < n8; i += gn) {
    const float4 a = *(const float4*)(src + i * 8), b = *(const float4*)(src + i * 8 + 4);
    uint4 w; w.x = cvtpk(a.x, a.y); w.y = cvtpk(a.z, a.w); w.z = cvtpk(b.x, b.y); w.w = cvtpk(b.z, b.w);
    *(uint4*)(dst + i * 8) = w;
  }
}
__device__ __forceinline__ void phase_prologue(const Params& p, unsigned char* lds) {
  unsigned char* ws = p.ws;
  const int tid = ltid(), lane = tid & 63, wave = tid >> 6;
  const int nb = gridDim.x, bid = blockIdx.x;
  float* tl = (float*)lds;
  constexpr int PER_L = 672 + 256 + 512;
  for (int it = bid; it < NL * PER_L; it += nb) {
    const int l = it / PER_L; int r = it % PER_L;
    if (r < 672) { transpose_tile(p.in[I_WIN] + (size_t)l * DM * INC, DM, INC, (u16*)(ws + WS_WIN) + (size_t)l * INCP * DM, r / 42, r % 42, tl); }
    else if (r < 928) { r -= 672; transpose_tile(p.in[I_WOUT] + (size_t)l * DM * DM, DM, DM, (u16*)(ws + WS_WOUT) + (size_t)l * DM * DM, r / 16, r % 16, tl); }
    else { r -= 928; transpose_tile(p.in[I_WQ] + (size_t)l * DM * 2048, DM, 2048, (u16*)(ws + WS_WQ) + (size_t)l * 2048 * DM, r / 32, r % 32, tl); }
  }
  const size_t gtid = (size_t)bid * 256 + tid, gn = (size_t)nb * 256;
  for (int tb = 0; tb < 2 * NL; ++tb) {
    const float* src = p.in[(tb & 1) ? I_V : I_U] + (size_t)(tb >> 1) * NEXP * DM;
    unsigned char* dst = ws + ((tb & 1) ? WS_VB : WS_UB) + (size_t)(tb >> 1) * NEXP * DM;
    float* sdst = (float*)(ws + ((tb & 1) ? WS_SV : WS_SU)) + (size_t)(tb >> 1) * NEXP;
    for (int row0 = (bid * 4 + wave) * 4; row0 < NEXP; row0 += nb * 16) {
      float4 v[4][4];
#pragma unroll
      for (int r = 0; r < 4; ++r)
#pragma unroll
        for (int q = 0; q < 4; ++q) v[r][q] = *(const float4*)(src + (size_t)(row0 + r) * DM + lane * 16 + q * 4);
#pragma unroll
      for (int r = 0; r < 4; ++r) {
        float m = 0.f;
#pragma unroll
        for (int q = 0; q < 4; ++q) m = fmaxf(m, fmaxf(fmaxf(fabsf(v[r][q].x), fabsf(v[r][q].y)), fmaxf(fabsf(v[r][q].z), fabsf(v[r][q].w))));
#pragma unroll
        for (int o = 32; o; o >>= 1) m = fmaxf(m, __shfl_xor(m, o));
        m = fmaxf(m, 1e-30f);
        const float sc = 240.f / m;
        uint4 w; int t0;
        t0 = 0; t0 = __builtin_amdgcn_cvt_pk_fp8_f32(v[r][0].x * sc, v[r][0].y * sc, t0, false); t0 = __builtin_amdgcn_cvt_pk_fp8_f32(v[r][0].z * sc, v[r][0].w * sc, t0, true); w.x = (unsigned)t0;
        t0 = 0; t0 = __builtin_amdgcn_cvt_pk_fp8_f32(v[r][1].x * sc, v[r][1].y * sc, t0, false); t0 = __builtin_amdgcn_cvt_pk_fp8_f32(v[r][1].z * sc, v[r][1].w * sc, t0, true); w.y = (unsigned)t0;
        t0 = 0; t0 = __builtin_amdgcn_cvt_pk_fp8_f32(v[r][2].x * sc, v[r][2].y * sc, t0, false); t0 = __builtin_amdgcn_cvt_pk_fp8_f32(v[r][2].z * sc, v[r][2].w * sc, t0, true); w.z = (unsigned)t0;
        t0 = 0; t0 = __builtin_amdgcn_cvt_pk_fp8_f32(v[r][3].x * sc, v[r][3].y * sc, t0, false); t0 = __builtin_amdgcn_cvt_pk_fp8_f32(v[r][3].z * sc, v[r][3].w * sc, t0, true); w.w = (unsigned)t0;
        *(uint4*)(dst + (size_t)(row0 + r) * DM + lane * 16) = w;
        if (lane == 0) sdst[row0 + r] = m * (1.f / 240.f);
      }
    }
  }
  convert8(p.in[I_K1], (u16*)(ws + WS_K1), (size_t)NL * 128 * 128 / 8, gtid, gn);
  convert8(p.in[I_K2], (u16*)(ws + WS_K2), (size_t)NL * 128 * 128 / 8, gtid, gn);
  for (size_t i = gtid; i < (size_t)NL * 4 * 128 * 128; i += gn) {
    const int s = (int)(i & 127), t = (int)((i >> 7) & 127);
    const float v = ((s >> 6) <= (t >> 6)) ? p.in[I_SW][i] : 0.f;
    ((u16*)(ws + WS_SGUW))[i] = f2bf(v);
  }
  float* H = (float*)(ws + WS_H); u16* HB = (u16*)(ws + WS_HB);
  for (int row = bid * 4 + wave; row < T_TOK; row += nb * 4) {
    float y[16];
    load_row16(p.in[I_X] + (size_t)row * DM, lane, y);
    ln_row(y, p.in[I_LNIG], p.in[I_LNIB], lane, H + (size_t)row * DM, HB + (size_t)row * DM);
  }
}

template <int NT>
__device__ __forceinline__ bool xcd_tile(int j, int& mb, int& nb) {
  const int xcd = blockIdx.x & 7;
  const int grp = j / (8 * NT), r = j % (8 * NT);
  mb = xcd * 16 + grp * 8 + (r & 7); nb = r >> 3;
  return grp < 2;
}
struct EpiInproj {
  u16* P; int m0, n0;
  __device__ __forceinline__ void pre(int, int, int) {}
  __device__ __forceinline__ void operator()(int r, int c, float v, int) const {
    const int col = n0 + c;
    if (col < INC) {
      if (col < 256) v *= 0.125f;
      else if (col >= C_SU) v = gelu_f(v);
      P[(size_t)(m0 + r) * PLD + col] = f2bf(v);
    }
  }
};
__device__ __forceinline__ void phase_inproj(const Params& p, int l, unsigned char* lds) {
  const u16* A = (const u16*)(p.ws + WS_HB);
  const u16* B = (const u16*)(p.ws + WS_WIN) + (size_t)l * INCP * DM;
  u16* P = (u16*)(p.ws + WS_P);
  constexpr int NB_N = INCP / 128;
  for (int j = blockIdx.x >> 3; ; j += gridDim.x >> 3) {
    int mb, nbk; if (!xcd_tile<NB_N>(j, mb, nbk)) break;
    EpiInproj e{P, mb * 128, nbk * 128};
    gemm_tile<128, 128, 64>(A, B, DM, mb * 128, nbk * 128, lds, e);
  }
}

typedef short v4i16_t __attribute__((ext_vector_type(4)));
__device__ __forceinline__ bf16x8 tr_bfrag(const u16* img, int ld, int k0, int n0, int lr, int lq) {
  const u16* a0 = img + (k0 + 8 * lq + (lr >> 2)) * ld + n0 + 4 * (lr & 3);
  const v4i16_t lo = __builtin_amdgcn_ds_read_tr16_b64_v4i16((__attribute__((address_space(3))) v4i16_t*)a0);
  const v4i16_t hi = __builtin_amdgcn_ds_read_tr16_b64_v4i16((__attribute__((address_space(3))) v4i16_t*)(a0 + 4 * ld));
  return __builtin_shufflevector(lo, hi, 0, 1, 2, 3, 4, 5, 6, 7);
}
__device__ __forceinline__ void gla_bcum(const u16* __restrict__ Pm, const float* __restrict__ wgu, const float* __restrict__ bg,
                                         int tok0, int h, float* bc, float* a_s, float* wg_s, float* tot) {
  const int tid = ltid();
  {
    const int t = tid >> 2, q = tid & 3, r = tid >> 4, k4 = (tid & 15) * 4;
    const uint2 aw = *(const uint2*)(Pm + (size_t)(tok0 + t) * PLD + C_A + q * 4);
    const float4 wv = *(const float4*)(wgu + r * 256 + h * 64 + k4);
    const float bgv = bg[h * 64 + (tid & 63)];
    a_s[t * 16 + q * 4 + 0] = bflo(aw.x); a_s[t * 16 + q * 4 + 1] = bfhi(aw.x); a_s[t * 16 + q * 4 + 2] = bflo(aw.y); a_s[t * 16 + q * 4 + 3] = bfhi(aw.y);
    wg_s[r * 64 + k4 + 0] = wv.x; wg_s[r * 64 + k4 + 1] = wv.y; wg_s[r * 64 + k4 + 2] = wv.z; wg_s[r * 64 + k4 + 3] = wv.w;
    if (tid < 64) wg_s[1024 + tid] = bgv;
  }
  __syncthreads();
  {
    const int k = tid & 63, qt = tid >> 6;
    float wcol[16];
#pragma unroll
    for (int r = 0; r < 16; ++r) wcol[r] = wg_s[r * 64 + k];
    const float bgk = wg_s[1024 + k];
    float lg[16];
    float c = 0.f;
#pragma unroll
    for (int j = 0; j < 16; ++j) {
      const float4* ap = (const float4*)(a_s + (qt * 16 + j) * 16);
      const float4 a0 = ap[0], a1 = ap[1], a2 = ap[2], a3 = ap[3];
      float sacc = bgk;
      sacc += a0.x * wcol[0]; sacc += a0.y * wcol[1]; sacc += a0.z * wcol[2]; sacc += a0.w * wcol[3];
      sacc += a1.x * wcol[4]; sacc += a1.y * wcol[5]; sacc += a1.z * wcol[6]; sacc += a1.w * wcol[7];
      sacc += a2.x * wcol[8]; sacc += a2.y * wcol[9]; sacc += a2.z * wcol[10]; sacc += a2.w * wcol[11];
      sacc += a3.x * wcol[12]; sacc += a3.y * wcol[13]; sacc += a3.z * wcol[14]; sacc += a3.w * wcol[15];
      c += logsig(sacc) * (1.f / 16.f);
      lg[j] = c;
    }
    tot[qt * 64 + k] = c;
    __syncthreads();
    float pre = 0.f;
    for (int q = 0; q < qt; ++q) pre += tot[q * 64 + k];
#pragma unroll
    for (int j = 0; j < 16; ++j) bc[(qt * 16 + j) * 65 + k] = lg[j] + pre;
  }
  __syncthreads();
}

__device__ __forceinline__ void gla_passA_item(const Params& p, int l, int item, unsigned char* lds) {
  const int tid = ltid(), lane = tid & 63, wave = tid >> 6, lr = lane & 15, lq = lane >> 4;
  const int bh = item >> 5, n = item & 31, b = bh >> 2, h = bh & 3;
  const int tok0 = b * 2048 + n * 64;
  const u16* Pm = (const u16*)(p.ws + WS_P);
  float* bc = (float*)lds;
  u16* kdT = (u16*)(lds + 16640);
  u16* vT = (u16*)(lds + 16640 + 9216);
  float* a_s = (float*)(lds + 16640 + 9216 + 18432);
  float* wg_s = a_s + 1024;
  float* tot = wg_s + 1088;
  gla_bcum(Pm, p.in[I_WGU] + (size_t)l * 16 * 256, p.in[I_BG] + (size_t)l * 256, tok0, h, bc, a_s, wg_s, tot);
  {
    u32x4 rk[2], rv[4], rq[2];
#pragma unroll
    for (int m = 0; m < 2; ++m) { const int i = tid + m * 256, s = i >> 3, k0 = (i & 7) * 8; const u16* gp = Pm + (size_t)(tok0 + s) * PLD + C_K + h * 64 + k0; GLD_B128(rk[m], gp); const u16* gq = gp - (C_K - C_Q); GLD_B128(rq[m], gq); }
#pragma unroll
    for (int m = 0; m < 4; ++m) { const int i = tid + m * 256, s = i >> 4, v0 = (i & 15) * 8; const u16* gp = Pm + (size_t)(tok0 + s) * PLD + C_V + h * 128 + v0; GLD_B128(rv[m], gp); }
    VM_WAIT0();
#pragma unroll
    for (int m = 0; m < 2; ++m) {
      const int i = tid + m * 256, s = i >> 3, k0 = (i & 7) * 8;
      float f[8]; unpack8(rk[m], f);
      float fq[8]; unpack8(rq[m], fq);
      unsigned wq[4], wk[4];
      {
        unsigned wl[4];
#pragma unroll
        for (int j = 0; j < 4; ++j)
          wl[j] = cvtpk(f[2 * j] * __expf(bc[63 * 65 + k0 + 2 * j] - bc[s * 65 + k0 + 2 * j]), f[2 * j + 1] * __expf(bc[63 * 65 + k0 + 2 * j + 1] - bc[s * 65 + k0 + 2 * j + 1]));
        *(uint4*)(kdT + s * 72 + k0) = make_uint4(wl[0], wl[1], wl[2], wl[3]);
      }
#pragma unroll
      for (int j = 0; j < 4; ++j) {
        const float b0 = bc[s * 65 + k0 + 2 * j], b1 = bc[s * 65 + k0 + 2 * j + 1];
        wq[j] = cvtpk(fq[2 * j] * __expf(b0), fq[2 * j + 1] * __expf(b1));
        wk[j] = cvtpk(f[2 * j] * __expf(-b0), f[2 * j + 1] * __expf(-b1));
      }
      u16* qdkd = (u16*)(p.ws + WS_QDKD) + (size_t)item * 2 * 4096;
      *(uint4*)(qdkd + s * 64 + k0) = make_uint4(wq[0], wq[1], wq[2], wq[3]);
      *(uint4*)(qdkd + 4096 + s * 64 + k0) = make_uint4(wk[0], wk[1], wk[2], wk[3]);
    }
#pragma unroll
    for (int m = 0; m < 4; ++m) {
      const int i = tid + m * 256, s = i >> 4, v0 = (i & 15) * 8;
      *(u32x4*)(vT + s * 136 + v0) = rv[m];
    }
  }
  __syncthreads();
  f32x4 acc[8];
#pragma unroll
  for (int j = 0; j < 8; ++j) acc[j] = (f32x4){0.f, 0.f, 0.f, 0.f};
#pragma unroll
  for (int ks = 0; ks < 2; ++ks) {
    const bf16x8 a = tr_bfrag(kdT, 72, ks * 32, wave * 16, lr, lq);
#pragma unroll
    for (int j = 0; j < 8; ++j) {
      const bf16x8 bb = tr_bfrag(vT, 136, ks * 32, j * 16, lr, lq);
      acc[j] = __builtin_amdgcn_mfma_f32_16x16x32_bf16(a, bb, acc[j], 0, 0, 0);
    }
  }
  float* KC = (float*)(p.ws + WS_KC) + (size_t)item * 64 * 128;
#pragma unroll
  for (int j = 0; j < 8; ++j)
#pragma unroll
    for (int r = 0; r < 4; ++r) KC[(wave * 16 + lq * 4 + r) * 128 + j * 16 + lr] = acc[j][r];
  if (tid < 64) ((float*)(p.ws + WS_DEC))[item * 64 + tid] = __expf(bc[63 * 65 + tid]);
  __syncthreads();
}

__device__ __forceinline__ void sgu_item(const Params& p, int l, int item, unsigned char* lds) {
  const int tid = ltid(), lane = tid & 63, wave = tid >> 6, lr = lane & 15, lq = lane >> 4;
  const int win = item >> 2, g = item & 3;
  const int tok0 = win * 128;
  const u16* Pm = (const u16*)(p.ws + WS_P);
  float* mean_s = (float*)lds; float* rstd_s = mean_s + 128;
  u16* vT = (u16*)(lds + 1024);
#pragma unroll 1
  for (int b8 = 0; b8 < 2; ++b8) {
    u32x4 rw[16];
#pragma unroll
    for (int i = 0; i < 16; ++i) { const int s = wave * 32 + b8 * 16 + i; const u16* gp = Pm + (size_t)(tok0 + s) * PLD + C_SV + lane * 8; GLD_B128(rw[i], gp); }
    VM_WAIT0();
#pragma unroll
    for (int i = 0; i < 16; ++i) {
      const int s = wave * 32 + b8 * 16 + i;
      float f[8]; unpack8(rw[i], f);
      const float sm = f[0] + f[1] + f[2] + f[3] + f[4] + f[5] + f[6] + f[7];
      const float mean = wave_sum(sm) * (1.f / 512.f);
      float sq = 0.f;
#pragma unroll
      for (int j = 0; j < 8; ++j) { const float d = f[j] - mean; sq += d * d; }
      const float var = wave_sum(sq) * (1.f / 512.f);
      if (lane == 0) { mean_s[s] = mean; rstd_s[s] = rsqrtf(var + LN_EPS); }
    }
  }
  __syncthreads();
  float bsv[8];
#pragma unroll
  for (int i = 0; i < 2; ++i)
#pragma unroll
    for (int r = 0; r < 4; ++r) bsv[i * 4 + r] = p.in[I_SB][((size_t)l * 4 + g) * 128 + wave * 32 + i * 16 + lq * 4 + r];
  u32x4 ru[8];
  {
    const int c0 = (tid & 15) * 8;
    const float* lng = p.in[I_SLG] + (size_t)l * 512 + g * 128 + c0;
    const float* lnb = p.in[I_SLB] + (size_t)l * 512 + g * 128 + c0;
    u32x4 rv[8];
#pragma unroll
    for (int m = 0; m < 8; ++m) { const int i = tid + m * 256, s = i >> 4; const u16* gv = Pm + (size_t)(tok0 + s) * PLD + C_SV + g * 128 + c0; const u16* gu = Pm + (size_t)(tok0 + s) * PLD + C_SU + g * 128 + c0; GLD_B128(rv[m], gv); GLD_B128(ru[m], gu); }
    const float4 ga = *(const float4*)(lng), gb = *(const float4*)(lng + 4), ba = *(const float4*)(lnb), bb = *(const float4*)(lnb + 4);
    const float gg[8] = {ga.x, ga.y, ga.z, ga.w, gb.x, gb.y, gb.z, gb.w}, bbv[8] = {ba.x, ba.y, ba.z, ba.w, bb.x, bb.y, bb.z, bb.w};
    VM_WAIT0();
#pragma unroll
    for (int m = 0; m < 8; ++m) {
      const int i = tid + m * 256, s = i >> 4;
      float f[8]; unpack8(rv[m], f);
      const float mu = mean_s[s], rs = rstd_s[s];
      unsigned wn[4];
#pragma unroll
      for (int j = 0; j < 4; ++j) wn[j] = cvtpk((f[2 * j] - mu) * rs * gg[2 * j] + bbv[2 * j], (f[2 * j + 1] - mu) * rs * gg[2 * j + 1] + bbv[2 * j + 1]);
      *(uint4*)(vT + s * 136 + c0) = make_uint4(wn[0], wn[1], wn[2], wn[3]);
    }
  }
  __syncthreads();
  const u16* W = (const u16*)(p.ws + WS_SGUW) + ((size_t)l * 4 + g) * 128 * 128;
  f32x4 acc[2][8];
#pragma unroll
  for (int i = 0; i < 2; ++i)
#pragma unroll
    for (int j = 0; j < 8; ++j) acc[i][j] = (f32x4){0.f, 0.f, 0.f, 0.f};
  const int nks = (wave < 2) ? 2 : 4;
  for (int ks = 0; ks < nks; ++ks) {
    bf16x8 a[2];
#pragma unroll
    for (int i = 0; i < 2; ++i) a[i] = *(const bf16x8*)(W + (size_t)(wave * 32 + i * 16 + lr) * 128 + ks * 32 + lq * 8);
#pragma unroll
    for (int j = 0; j < 8; ++j) {
      const bf16x8 bb = tr_bfrag(vT, 136, ks * 32, j * 16, lr, lq);
#pragma unroll
      for (int i = 0; i < 2; ++i) acc[i][j] = __builtin_amdgcn_mfma_f32_16x16x32_bf16(a[i], bb, acc[i][j], 0, 0, 0);
    }
  }
  const float* bs = p.in[I_SB] + ((size_t)l * 4 + g) * 128;
  u16* MC = (u16*)(p.ws + WS_MC);
  u16* uT = vT;
  __syncthreads();
#pragma unroll
  for (int m = 0; m < 8; ++m) { const int i = tid + m * 256, t = i >> 4, c0 = (i & 15) * 8; *(u32x4*)(uT + t * 136 + c0) = ru[m]; }
  __syncthreads();
#pragma unroll
  for (int i = 0; i < 2; ++i)
#pragma unroll
    for (int r = 0; r < 4; ++r) {
      const int t = wave * 32 + i * 16 + lq * 4 + r;
      const float bias = bsv[i * 4 + r];
#pragma unroll
      for (int j = 0; j < 8; ++j) {
        const int c = j * 16 + lr;
        const float u = bf2f(uT[t * 136 + c]);
        MC[(size_t)(tok0 + t) * DM + 512 + g * 128 + c] = f2bf((acc[i][j][r] + bias) * u);
      }
    }
  __syncthreads();
}

__device__ __forceinline__ void scan_item(const Params& p, int item) {
  const int e = item * 256 + ltid();
  const int bh = e >> 13, k = (e >> 7) & 63, v = e & 127;
  const float* KC = (const float*)(p.ws + WS_KC);
  const float* DEC = (const float*)(p.ws + WS_DEC);
  u16* ST = (u16*)(p.ws + WS_ST);
  float S = 0.f;
#pragma unroll 1
  for (int n8 = 0; n8 < 2; ++n8) {
    unsigned kc[16], dc[16];
#pragma unroll
    for (int j = 0; j < 16; ++j) {
      const int n = n8 * 16 + j;
      const float* gk = KC + ((size_t)(bh * 32 + n) * 64 + k) * 128 + v; const float* gd = DEC + (bh * 32 + n) * 64 + k;
      GLD_B32(kc[j], gk); GLD_B32(dc[j], gd);
    }
    VM_WAIT0();
#pragma unroll
    for (int j = 0; j < 16; ++j) {
      const int n = n8 * 16 + j;
      ST[((size_t)(bh * 32 + n) * 64 + k) * 128 + v] = f2bf(S);
      S = __uint_as_float(dc[j]) * S + __uint_as_float(kc[j]);
    }
  }
}

__device__ __forceinline__ void gla_passC_item(const Params& p, int l, int item, unsigned char* lds) {
  const int tid = ltid(), lane = tid & 63, wave = tid >> 6, lr = lane & 15, lq = lane >> 4;
  const int bh = item >> 5, n = item & 31, b = bh >> 2, h = bh & 3;
  const int tok0 = b * 2048 + n * 64;
  const u16* Pm = (const u16*)(p.ws + WS_P);
  u16* attn = (u16*)lds;
  u16* qd = (u16*)(lds + 16640);
  u16* kd = (u16*)(lds + 16640 + 9216);
  u16* vT = (u16*)(lds + 16640 + 18432);
  u16* stT = (u16*)(lds + 16640 + 36864);
  const u16* ST = (const u16*)(p.ws + WS_ST) + (size_t)item * 64 * 128;
  float gnv[8];
#pragma unroll
  for (int j = 0; j < 8; ++j) gnv[j] = p.in[I_GNG][(size_t)l * 128 + j * 16 + lr];
  u32x4 rr4[4];
  {
    u32x4 rq[2], rk[2], rv[4], rs[4];
    const u16* qdkd = (const u16*)(p.ws + WS_QDKD) + (size_t)item * 2 * 4096;
#pragma unroll
    for (int m = 0; m < 2; ++m) { const int i = tid + m * 256, t = i >> 3, k0 = (i & 7) * 8; const u16* gq = qdkd + t * 64 + k0; const u16* gk = gq + 4096; GLD_B128(rq[m], gq); GLD_B128(rk[m], gk); }
#pragma unroll
    for (int m = 0; m < 4; ++m) { const int i = tid + m * 256, s = i >> 4, v0 = (i & 15) * 8; const u16* gv = Pm + (size_t)(tok0 + s) * PLD + C_V + h * 128 + v0; const u16* gs = ST + s * 128 + v0; const u16* gr = Pm + (size_t)(tok0 + s) * PLD + C_R + h * 128 + v0;
      GLD_B128(rv[m], gv); GLD_B128(rs[m], gs); GLD_B128(rr4[m], gr); }
    VM_WAIT0();
#pragma unroll
    for (int m = 0; m < 2; ++m) {
      const int i = tid + m * 256, t = i >> 3, k0 = (i & 7) * 8;
      *(u32x4*)(qd + t * 72 + k0) = rq[m];
      *(u32x4*)(kd + t * 72 + k0) = rk[m];
    }
#pragma unroll
    for (int m = 0; m < 4; ++m) {
      const int i = tid + m * 256, s = i >> 4, v0 = (i & 15) * 8;
      *(u32x4*)(vT + s * 136 + v0) = rv[m];
      *(u32x4*)(stT + s * 136 + v0) = rs[m];
    }
  }
  __syncthreads();
  {
    f32x4 sa[4];
#pragma unroll
    for (int j = 0; j < 4; ++j) sa[j] = (f32x4){0.f, 0.f, 0.f, 0.f};
#pragma unroll
    for (int ks = 0; ks < 2; ++ks) {
      const bf16x8 a = *(const bf16x8*)(qd + (wave * 16 + lr) * 72 + ks * 32 + lq * 8);
#pragma unroll
      for (int j = 0; j < 4; ++j) {
        const bf16x8 bb = *(const bf16x8*)(kd + (j * 16 + lr) * 72 + ks * 32 + lq * 8);
        sa[j] = __builtin_amdgcn_mfma_f32_16x16x32_bf16(a, bb, sa[j], 0, 0, 0);
      }
    }
#pragma unroll
    for (int j = 0; j < 4; ++j)
#pragma unroll
      for (int r = 0; r < 4; ++r) {
        const int t = wave * 16 + lq * 4 + r, s = j * 16 + lr;
        attn[t * 72 + s] = f2bf((s <= t) ? sa[j][r] : 0.f);
      }
  }
  __syncthreads();
  f32x4 acc[8];
#pragma unroll
  for (int j = 0; j < 8; ++j) acc[j] = (f32x4){0.f, 0.f, 0.f, 0.f};
#pragma unroll
  for (int ks = 0; ks < 2; ++ks) {
    const bf16x8 a = *(const bf16x8*)(attn + (wave * 16 + lr) * 72 + ks * 32 + lq * 8);
#pragma unroll
    for (int j = 0; j < 8; ++j) {
      const bf16x8 bb = tr_bfrag(vT, 136, ks * 32, j * 16, lr, lq);
      acc[j] = __builtin_amdgcn_mfma_f32_16x16x32_bf16(a, bb, acc[j], 0, 0, 0);
    }
  }
#pragma unroll
  for (int ks = 0; ks < 2; ++ks) {
    const bf16x8 a = *(const bf16x8*)(qd + (wave * 16 + lr) * 72 + ks * 32 + lq * 8);
#pragma unroll
    for (int j = 0; j < 8; ++j) {
      const bf16x8 bb = tr_bfrag(stT, 136, ks * 32, j * 16, lr, lq);
      acc[j] = __builtin_amdgcn_mfma_f32_16x16x32_bf16(a, bb, acc[j], 0, 0, 0);
    }
  }
  const float* gn = p.in[I_GNG] + (size_t)l * 128;
  u16* MC = (u16*)(p.ws + WS_MC);
  u16* rT = vT;
  __syncthreads();
#pragma unroll
  for (int m = 0; m < 4; ++m) { const int i = tid + m * 256, t = i >> 4, v0 = (i & 15) * 8; *(u32x4*)(rT + t * 136 + v0) = rr4[m]; }
  __syncthreads();
#pragma unroll
  for (int r = 0; r < 4; ++r) {
    float ss = 0.f;
#pragma unroll
    for (int j = 0; j < 8; ++j) ss += acc[j][r] * acc[j][r];
    ss += __shfl_xor(ss, 1); ss += __shfl_xor(ss, 2); ss += __shfl_xor(ss, 4); ss += __shfl_xor(ss, 8);
    const float rinv = rsqrtf(ss * (1.f / 128.f) + LN_EPS);
    const int t = wave * 16 + lq * 4 + r;
#pragma unroll
    for (int j = 0; j < 8; ++j) {
      const int v = j * 16 + lr;
      const float rr = bf2f(rT[t * 136 + v]);
      const float sil = rr / (1.f + __expf(-rr));
      MC[(size_t)(tok0 + t) * DM + h * 128 + v] = f2bf(acc[j][r] * rinv * gnv[j] * sil);
    }
  }
  __syncthreads();
}

struct EpiOutproj {
  const float* H; float* O; int m0, n0; float hv[64];
  __device__ __forceinline__ void pre(int r, int c, int slot) { hv[slot] = H[(size_t)(m0 + r) * DM + n0 + c]; }
  __device__ __forceinline__ void operator()(int r, int c, float v, int slot) const {
    const size_t idx = (size_t)(m0 + r) * DM + n0 + c;
    O[idx] = ALPHA * hv[slot] + v;
  }
};
__device__ __forceinline__ void phase_outproj(const Params& p, int l, unsigned char* lds) {
  const u16* A = (const u16*)(p.ws + WS_MC);
  const u16* B = (const u16*)(p.ws + WS_WOUT) + (size_t)l * DM * DM;
  for (int j = blockIdx.x >> 3; ; j += gridDim.x >> 3) {
    int mb, nbk; if (!xcd_tile<8>(j, mb, nbk)) break;
    EpiOutproj e; e.H = (const float*)(p.ws + WS_H); e.O = p.out; e.m0 = mb * 128; e.n0 = nbk * 128;
    gemm_tile<128, 128, 64>(A, B, DM, mb * 128, nbk * 128, lds, e);
  }
}
__device__ __forceinline__ void phase_ln1(const Params& p, int l) {
  const int lane = ltid() & 63, wave = ltid() >> 6;
  float* H = (float*)(p.ws + WS_H); u16* HB = (u16*)(p.ws + WS_HB);
  for (int row = blockIdx.x * 4 + wave; row < T_TOK; row += gridDim.x * 4) {
    float y[16];
    load_row16(p.out + (size_t)row * DM, lane, y);
    ln_row(y, p.in[I_L1G] + (size_t)l * DM, p.in[I_L1B] + (size_t)l * DM, lane, H + (size_t)row * DM, HB + (size_t)row * DM);
  }
}

#define CE_DESC(a, b) { const unsigned hi_ = max(a, b), lo_ = min(a, b); a = hi_; b = lo_; }
template <int N>
__device__ __forceinline__ void bitonic_sort_desc(unsigned (&a)[N]) {
#pragma unroll
  for (int k = 2; k <= N; k <<= 1)
#pragma unroll
    for (int j = k >> 1; j > 0; j >>= 1)
#pragma unroll
      for (int i = 0; i < N; ++i) {
        const int l = i ^ j;
        if (l > i) {
          const unsigned hi = max(a[i], a[l]), lo = min(a[i], a[l]);
          if ((i & k) == 0) { a[i] = hi; a[l] = lo; } else { a[i] = lo; a[l] = hi; }
        }
      }
}
__device__ __forceinline__ void merge16_group4(unsigned (&a)[32]) {
#pragma unroll
  for (int step = 1; step <= 2; step <<= 1) {
    unsigned bq[16];
#pragma unroll
    for (int i = 0; i < 16; ++i) bq[i] = (unsigned)__shfl_xor((int)a[15 - i], step);
#pragma unroll
    for (int i = 0; i < 16; ++i) a[i] = max(a[i], bq[i]);
#pragma unroll
    for (int k = 8; k >= 1; k >>= 1)
#pragma unroll
      for (int i = 0; i < 16; ++i) if ((i & k) == 0) CE_DESC(a[i], a[i | k]);
  }
}
__device__ __forceinline__ void topk16_half(const float* sc_s, int t, int part, unsigned (&a)[32]) {
#pragma unroll
  for (int i = 0; i < 32; ++i) {
    const int nn = 4 * i + part;
    a[i] = (fkey(sc_s[t * 132 + nn]) & ~127u) | (unsigned)(127 - nn);
  }
  bitonic_sort_desc<32>(a);
  merge16_group4(a);
}
struct EpiQG {
  u16* Q; int m0, n0;
  __device__ __forceinline__ void pre(int, int, int) {}
  __device__ __forceinline__ void operator()(int r, int c, float v, int) const { Q[(size_t)(m0 + r) * 2048 + n0 + c] = f2bf(v); }
};
__device__ __forceinline__ void phase_q(const Params& p, int l, unsigned char* lds, u16* Qg) {
  const u16* A = (const u16*)(p.ws + WS_HB);
  const u16* B = (const u16*)(p.ws + WS_WQ) + (size_t)l * 2048 * DM;
  for (int j = blockIdx.x >> 3; ; j += gridDim.x >> 3) {
    int mb, nbk; if (!xcd_tile<16>(j, mb, nbk)) break;
    EpiQG e{Qg, mb * 128, nbk * 128};
    gemm_tile<128, 128, 64>(A, B, DM, mb * 128, nbk * 128, lds, e);
  }
}
__device__ __forceinline__ void phase_route(const Params& p, int l, unsigned char* lds, const u16* Qg) {
  const int tid = ltid(), lane = tid & 63, wave = tid >> 6, lr = lane & 15, lq = lane >> 4;
  u16* q_s = (u16*)lds;
  float* sc_s = (float*)(lds + 33792);
  u16* kb_s = (u16*)(lds + 33792);
  unsigned* key_s = (unsigned*)(lds + 68608);
  int* EIDX = (int*)(p.ws + WS_EIDX); float* GATE = (float*)(p.ws + WS_GATE);
  for (int it = blockIdx.x; it < (T_TOK / 64) * 8; it += gridDim.x) {
    const int mb = it >> 3, hd = it & 7;
    {
      u32x4 rq[8];
#pragma unroll
      for (int m = 0; m < 8; ++m) { const int i = tid + m * 256, r = i >> 5, c8 = i & 31; const u16* gp = Qg + (size_t)(mb * 64 + r) * 2048 + hd * 256 + c8 * 8; GLD_B128(rq[m], gp); }
      VM_WAIT0();
#pragma unroll
      for (int m = 0; m < 8; ++m) { const int i = tid + m * 256, r = i >> 5, c8 = i & 31; *(u32x4*)(q_s + r * 264 + c8 * 8) = rq[m]; }
    }
    __syncthreads();
    const int t = tid >> 2, part = tid & 3;
#pragma unroll 1
    for (int half = 0; half < 2; ++half) {
      const u16* Kb = (const u16*)(p.ws + (half ? WS_K2 : WS_K1)) + (size_t)l * 128 * 128;
      __syncthreads();
      {
        u32x4 rk[8];
#pragma unroll
        for (int m = 0; m < 8; ++m) { const int i = tid + m * 256, n = i >> 4, c8 = i & 15; rk[m] = *(const u32x4*)(Kb + (size_t)n * 128 + c8 * 8); }
#pragma unroll
        for (int m = 0; m < 8; ++m) { const int i = tid + m * 256, n = i >> 4, c8 = i & 15; *(u32x4*)(kb_s + n * 136 + c8 * 8) = rk[m]; }
      }
      __syncthreads();
      f32x4 sa[8];
#pragma unroll
      for (int j = 0; j < 8; ++j) sa[j] = (f32x4){0.f, 0.f, 0.f, 0.f};
#pragma unroll
      for (int ks = 0; ks < 4; ++ks) {
        const bf16x8 a = *(const bf16x8*)(q_s + (wave * 16 + lr) * 264 + half * 128 + ks * 32 + lq * 8);
#pragma unroll
        for (int j = 0; j < 8; ++j) {
          const bf16x8 bb = *(const bf16x8*)(kb_s + (j * 16 + lr) * 136 + ks * 32 + lq * 8);
          sa[j] = __builtin_amdgcn_mfma_f32_16x16x32_bf16(a, bb, sa[j], 0, 0, 0);
        }
      }
      __syncthreads();
#pragma unroll
      for (int j = 0; j < 8; ++j)
#pragma unroll
        for (int r = 0; r < 4; ++r) sc_s[(wave * 16 + lq * 4 + r) * 132 + j * 16 + lr] = sa[j][r];
      __syncthreads();
      unsigned a[32];
      topk16_half(sc_s, t, part, a);
      if (part == 0) {
#pragma unroll
        for (int w = 0; w < 4; ++w) *(uint4*)(key_s + t * 32 + half * 16 + 4 * w) = make_uint4(a[4 * w], a[4 * w + 1], a[4 * w + 2], a[4 * w + 3]);
      }
    }
    __syncthreads();
    {
      const unsigned* k1p = key_s + t * 32; const unsigned* k2p = k1p + 16;
      float v2[16];
#pragma unroll
      for (int j = 0; j < 16; ++j) v2[j] = funkey(k2p[j] & ~127u);
      unsigned c[32];
#pragma unroll
      for (int i = 0; i < 32; ++i) c[i] = 0u;
      {
        const int i0 = part; const float v1 = funkey(k1p[i0] & ~127u); const int nj = 16 / (i0 + 1);
#pragma unroll
        for (int j = 0; j < 16; ++j) c[j] = (j < nj) ? ((fkey(v1 + v2[j]) & ~255u) | (unsigned)(255 - (i0 * 16 + j))) : 0u;
      }
      {
        const int i1 = part + 4; const float v1 = funkey(k1p[i1] & ~127u); const int nj = 16 / (i1 + 1);
#pragma unroll
        for (int j = 0; j < 3; ++j) c[16 + j] = (j < nj) ? ((fkey(v1 + v2[j]) & ~255u) | (unsigned)(255 - (i1 * 16 + j))) : 0u;
      }
      { const int i2 = part + 8;  const float v1 = funkey(k1p[i2] & ~127u); c[19] = (fkey(v1 + v2[0]) & ~255u) | (unsigned)(255 - (i2 * 16)); }
      { const int i3 = part + 12; const float v1 = funkey(k1p[i3] & ~127u); c[20] = (fkey(v1 + v2[0]) & ~255u) | (unsigned)(255 - (i3 * 16)); }
      bitonic_sort_desc<32>(c);
      merge16_group4(c);
      const float m = funkey(c[0] & ~255u);
      float ex[16]; float ssum = 0.f;
#pragma unroll
      for (int r = 0; r < 16; ++r) { ex[r] = __expf(funkey(c[r] & ~255u) - m); ssum += ex[r]; }
      const float inv = 1.f / ssum;
      int ei4[4]; float g4[4];
#pragma unroll
      for (int w = 0; w < 4; ++w) {
        const unsigned ck = (part == 0) ? c[w] : (part == 1) ? c[4 + w] : (part == 2) ? c[8 + w] : c[12 + w];
        const float ev = (part == 0) ? ex[w] : (part == 1) ? ex[4 + w] : (part == 2) ? ex[8 + w] : ex[12 + w];
        const unsigned pos = 255u - (ck & 255u);
        const int i1 = 127 - (int)(k1p[pos >> 4] & 127u), i2 = 127 - (int)(k2p[pos & 15] & 127u);
        ei4[w] = i1 * 128 + i2; g4[w] = ev * inv;
      }
      const size_t base = ((size_t)hd * T_TOK + mb * 64 + t) * 16 + part * 4;
      *(int4*)(EIDX + base) = make_int4(ei4[0], ei4[1], ei4[2], ei4[3]);
      *(float4*)(GATE + base) = make_float4(g4[0], g4[1], g4[2], g4[3]);
    }
    __syncthreads();
  }
}

typedef float f32x2 __attribute__((ext_vector_type(2)));
__device__ __forceinline__ void ln_row_c(float (&y)[16], const float* __restrict__ g, const float* __restrict__ b, int lane,
                                         float* __restrict__ outf, u16* __restrict__ outb) {
  float s = 0.f;
#pragma unroll
  for (int i = 0; i < 16; ++i) s += y[i];
  const float mean = wave_sum(s) * (1.f / 1024.f);
  float q = 0.f;
#pragma unroll
  for (int i = 0; i < 16; ++i) { y[i] -= mean; q += y[i] * y[i]; }
  const float rstd = rsqrtf(wave_sum(q) * (1.f / 1024.f) + LN_EPS);
  const int c0 = lane * 16;
  unsigned pk[8];
#pragma unroll
  for (int q4 = 0; q4 < 4; ++q4) {
    const float4 gg = *(const float4*)(g + c0 + q4 * 4), bb = *(const float4*)(b + c0 + q4 * 4);
    float4 o;
    o.x = y[q4 * 4 + 0] * rstd * gg.x + bb.x; o.y = y[q4 * 4 + 1] * rstd * gg.y + bb.y;
    o.z = y[q4 * 4 + 2] * rstd * gg.z + bb.z; o.w = y[q4 * 4 + 3] * rstd * gg.w + bb.w;
    *(float4*)(outf + c0 + q4 * 4) = o;
    pk[q4 * 2] = cvtpk(o.x, o.y); pk[q4 * 2 + 1] = cvtpk(o.z, o.w);
  }
  if (outb) {
    *(uint4*)(outb + c0) = make_uint4(pk[0], pk[1], pk[2], pk[3]);
    *(uint4*)(outb + c0 + 8) = make_uint4(pk[4], pk[5], pk[6], pk[7]);
  }
}
#define EXP_LOAD(buf, tab, g_) do { const int ev_ = ((g_) < 8) ? e0 : e1; \
  _Pragma("unroll") for (int e_ = 0; e_ < 8; ++e_) { const int idx_ = __builtin_amdgcn_readlane(ev_, ((g_) & 7) * 8 + e_); \
    buf[e_] = *(const uint4*)((tab) + (size_t)idx_ * DM + lane * 16); } } while (0)
__device__ __forceinline__ float dot16_fp8(const uint4& w, const f32x2 (&x2)[8]) {
  f32x2 acc = {0.f, 0.f};
  acc += __builtin_amdgcn_cvt_pk_f32_fp8((int)w.x, false) * x2[0]; acc += __builtin_amdgcn_cvt_pk_f32_fp8((int)w.x, true) * x2[1];
  acc += __builtin_amdgcn_cvt_pk_f32_fp8((int)w.y, false) * x2[2]; acc += __builtin_amdgcn_cvt_pk_f32_fp8((int)w.y, true) * x2[3];
  acc += __builtin_amdgcn_cvt_pk_f32_fp8((int)w.z, false) * x2[4]; acc += __builtin_amdgcn_cvt_pk_f32_fp8((int)w.z, true) * x2[5];
  acc += __builtin_amdgcn_cvt_pk_f32_fp8((int)w.w, false) * x2[6]; acc += __builtin_amdgcn_cvt_pk_f32_fp8((int)w.w, true) * x2[7];
  return acc[0] + acc[1];
}
__device__ __forceinline__ void axpy16_fp8(const uint4& w, float c, f32x2 (&o2)[8]) {
  const f32x2 cc = {c, c};
  o2[0] += cc * __builtin_amdgcn_cvt_pk_f32_fp8((int)w.x, false); o2[1] += cc * __builtin_amdgcn_cvt_pk_f32_fp8((int)w.x, true);
  o2[2] += cc * __builtin_amdgcn_cvt_pk_f32_fp8((int)w.y, false); o2[3] += cc * __builtin_amdgcn_cvt_pk_f32_fp8((int)w.y, true);
  o2[4] += cc * __builtin_amdgcn_cvt_pk_f32_fp8((int)w.z, false); o2[5] += cc * __builtin_amdgcn_cvt_pk_f32_fp8((int)w.z, true);
  o2[6] += cc * __builtin_amdgcn_cvt_pk_f32_fp8((int)w.w, false); o2[7] += cc * __builtin_amdgcn_cvt_pk_f32_fp8((int)w.w, true);
}
__device__ __forceinline__ void phase_expert(const Params& p, int l, unsigned char* lds, bool last) {
  const int tid = ltid(), lane = tid & 63, wave = tid >> 6;
  float* c_w = (float*)lds + wave * 2048;
  int* sw = (int*)(lds + 32768) + wave * 384;
  const unsigned char* U8 = p.ws + WS_UB + (size_t)l * NEXP * DM;
  const unsigned char* V8 = p.ws + WS_VB + (size_t)l * NEXP * DM;
  const float* SU = (const float*)(p.ws + WS_SU) + (size_t)l * NEXP;
  const float* SV = (const float*)(p.ws + WS_SV) + (size_t)l * NEXP;
  const int* EIDX = (const int*)(p.ws + WS_EIDX); const float* GATE = (const float*)(p.ws + WS_GATE);
  int* EP = (int*)(p.ws + WS_QG);
  float* GP = (float*)(p.ws + WS_QG) + (size_t)T_TOK * 128;
  float* UP = (float*)(p.ws + WS_QG) + (size_t)2 * T_TOK * 128;
  float* H = (float*)(p.ws + WS_H); u16* HB = (u16*)(p.ws + WS_HB);
  const int eperm = ((lane & 1) << 2) | (((lane >> 1) & 1) << 1) | ((lane >> 2) & 1);
  const int tstep = gridDim.x * 4;
#define LOAD_X2(t_) do { const float* xr = H + (size_t)(t_) * DM + lane * 16; \
    _Pragma("unroll") for (int q4 = 0; q4 < 4; ++q4) { const float4 a = *(const float4*)(xr + q4 * 4); x2[q4 * 2] = (f32x2){a.x, a.y}; x2[q4 * 2 + 1] = (f32x2){a.z, a.w}; } } while (0)
#define LOAD_X2B(t_) do { const u16* xr = HB + (size_t)(t_) * DM + lane * 16; \
    const u32x4 w0 = *(const u32x4*)(xr), w1 = *(const u32x4*)(xr + 8); \
    x2[0] = (f32x2){bflo(w0.x), bfhi(w0.x)}; x2[1] = (f32x2){bflo(w0.y), bfhi(w0.y)}; x2[2] = (f32x2){bflo(w0.z), bfhi(w0.z)}; x2[3] = (f32x2){bflo(w0.w), bfhi(w0.w)}; \
    x2[4] = (f32x2){bflo(w1.x), bfhi(w1.x)}; x2[5] = (f32x2){bflo(w1.y), bfhi(w1.y)}; x2[6] = (f32x2){bflo(w1.z), bfhi(w1.z)}; x2[7] = (f32x2){bflo(w1.w), bfhi(w1.w)}; } while (0)
#define U_PART(gb, NP) do { uint4 ba[8], bb[8]; \
    EXP_LOAD(ba, U8, (gb)); \
    _Pragma("unroll") for (int gp = 0; gp < (NP); ++gp) { \
      _Pragma("unroll") for (int hh = 0; hh < 2; ++hh) { \
        const int grp = (gb) + gp * 2 + hh; \
        if (hh == 0) { EXP_LOAD(bb, U8, grp + 1); } else if (gp < (NP) - 1) { EXP_LOAD(ba, U8, grp + 1); } \
        float pd[8]; \
        _Pragma("unroll") for (int e = 0; e < 8; ++e) pd[e] = dot16_fp8(hh == 0 ? ba[e] : bb[e], x2); \
        float q4v[4], r2[2], s1; \
        const bool b0 = lane & 1, b1 = (lane >> 1) & 1, b2 = (lane >> 2) & 1; \
        _Pragma("unroll") for (int i = 0; i < 4; ++i) { const float keep = b0 ? pd[i + 4] : pd[i], send = b0 ? pd[i] : pd[i + 4]; q4v[i] = keep + __shfl_xor(send, 1); } \
        _Pragma("unroll") for (int i = 0; i < 2; ++i) { const float keep = b1 ? q4v[i + 2] : q4v[i], send = b1 ? q4v[i] : q4v[i + 2]; r2[i] = keep + __shfl_xor(send, 2); } \
        { const float keep = b2 ? r2[1] : r2[0], send = b2 ? r2[0] : r2[1]; s1 = keep + __shfl_xor(send, 4); } \
        s1 += __shfl_xor(s1, 8); s1 += __shfl_xor(s1, 16); s1 += __shfl_xor(s1, 32); \
        const float gate = __shfl((grp < 8) ? gv0 : gv1, (grp & 7) * 8 + eperm); \
        const float usc = __shfl((grp < 8) ? su0 : su1, (grp & 7) * 8 + eperm); \
        const float cval = gelu_f(s1 * usc) * gate; \
        if (lane < 8) c_s[grp * 8 + eperm] = cval; \
      } } } while (0)
#define V_HALF(gb) do { uint4 ba[8], bb[8]; \
    EXP_LOAD(ba, V8, (gb)); \
    _Pragma("unroll 1") for (int gp = 0; gp < 4; ++gp) { \
      _Pragma("unroll") for (int hh = 0; hh < 2; ++hh) { \
        const int grp = (gb) + gp * 2 + hh; \
        if (hh == 0) { EXP_LOAD(bb, V8, grp + 1); } else if (gp < 3) { EXP_LOAD(ba, V8, grp + 1); } \
        _Pragma("unroll") for (int e = 0; e < 8; ++e) axpy16_fp8(hh == 0 ? ba[e] : bb[e], c_s[grp * 8 + e], o2); \
      } } } while (0)
  for (int tbase = blockIdx.x * 4 + wave; tbase < T_TOK; tbase += tstep * 16) {
    int slot = 0;
    for (int t = tbase; t < T_TOK && slot < 16; t += tstep, ++slot) {
      float* c_s = c_w + slot * 128;
      f32x2 x2[8];
      LOAD_X2B(t);
      const size_t eo0 = ((size_t)(lane >> 4) * T_TOK + t) * 16 + (lane & 15), eo1 = eo0 + (size_t)4 * T_TOK * 16;
      const int r0 = EIDX[eo0], r1 = EIDX[eo1];
      const float rg0 = GATE[eo0] * SV[r0], rg1 = GATE[eo1] * SV[r1], ru0 = SU[r0], ru1 = SU[r1];
      int e0, e1 = 0; float gv0, gv1 = 0.f, su0, su1 = 0.f;
      {
        const int q0 = r0 >> 12, q1 = r1 >> 12;
        const unsigned long long lt = (1ull << lane) - 1ull;
        int base = 0, pos0 = 0, pos1 = 0;
#pragma unroll
        for (int q = 0; q < 4; ++q) {
          const unsigned long long m0 = __ballot(q0 == q), m1 = __ballot(q1 == q);
          const int n0 = __popcll(m0), n1 = __popcll(m1);
          if (q0 == q) pos0 = base + __popcll(m0 & lt);
          if (q1 == q) pos1 = base + n0 + __popcll(m1 & lt);
          base += n0 + n1;
        }
        sw[pos0] = r0; sw[pos1] = r1;
        sw[128 + pos0] = __float_as_int(rg0); sw[128 + pos1] = __float_as_int(rg1);
        sw[256 + pos0] = __float_as_int(ru0); sw[256 + pos1] = __float_as_int(ru1);
        __builtin_amdgcn_fence(__ATOMIC_RELEASE, "workgroup");
        __builtin_amdgcn_wave_barrier();
        __builtin_amdgcn_fence(__ATOMIC_ACQUIRE, "workgroup");
        e0 = sw[lane]; const int e1p = sw[64 + lane];
        gv0 = __int_as_float(sw[128 + lane]); const float gv1p = __int_as_float(sw[192 + lane]);
        su0 = __int_as_float(sw[256 + lane]); const float su1p = __int_as_float(sw[320 + lane]);
        __builtin_amdgcn_fence(__ATOMIC_RELEASE, "workgroup");
        __builtin_amdgcn_wave_barrier();
        EP[(size_t)t * 128 + lane] = e0; EP[(size_t)t * 128 + 64 + lane] = e1p;
        GP[(size_t)t * 128 + lane] = gv0; GP[(size_t)t * 128 + 64 + lane] = gv1p;
        UP[(size_t)t * 128 + lane] = su0; UP[(size_t)t * 128 + 64 + lane] = su1p;
      }
      U_PART(0, 2);
    }
#pragma unroll 1
    for (int qtr = 1; qtr < 4; ++qtr) {
      slot = 0;
      for (int t = tbase; t < T_TOK && slot < 16; t += tstep, ++slot) {
        float* c_s = c_w + slot * 128;
        f32x2 x2[8];
        LOAD_X2B(t);
        const int hi = (qtr >= 2) ? 64 : 0;
        const int ev = EP[(size_t)t * 128 + hi + lane];
        const float gvv = GP[(size_t)t * 128 + hi + lane], suv = UP[(size_t)t * 128 + hi + lane];
        const int e0 = ev, e1 = ev; const float gv0 = gvv, gv1 = gvv, su0 = suv, su1 = suv;
        U_PART(qtr * 4, 2);
      }
    }
    __builtin_amdgcn_fence(__ATOMIC_RELEASE, "workgroup");
    __builtin_amdgcn_wave_barrier();
    __builtin_amdgcn_fence(__ATOMIC_ACQUIRE, "workgroup");
    slot = 0;
    for (int t = tbase; t < T_TOK && slot < 16; t += tstep, ++slot) {
      const float* c_s = c_w + slot * 128;
      f32x2 x2[8];
      LOAD_X2(t);
      const int e0 = EP[(size_t)t * 128 + lane], e1 = EP[(size_t)t * 128 + 64 + lane];
      f32x2 o2[8];
#pragma unroll
      for (int i = 0; i < 8; ++i) o2[i] = (f32x2){0.f, 0.f};
      V_HALF(0);
      V_HALF(8);
      float o[16];
#pragma unroll
      for (int i = 0; i < 8; ++i) { o[2 * i] = o2[i][0] + ALPHA * x2[i][0]; o[2 * i + 1] = o2[i][1] + ALPHA * x2[i][1]; }
      if (last) ln_row_c(o, p.in[I_L2G] + (size_t)l * DM, p.in[I_L2B] + (size_t)l * DM, lane, p.out + (size_t)t * DM, (u16*)nullptr);
      else ln_row_c(o, p.in[I_L2G] + (size_t)l * DM, p.in[I_L2B] + (size_t)l * DM, lane, H + (size_t)t * DM, HB + (size_t)t * DM);
    }
    __builtin_amdgcn_fence(__ATOMIC_RELEASE, "workgroup");
    __builtin_amdgcn_wave_barrier();
  }
#undef LOAD_X2
#undef LOAD_X2B
#undef U_PART
#undef V_HALF
}

#define XB_TMO      128
#define XB_XCNT(j)  (256  + 64 * (j))
#define XB_XSUB(j)  (1280 + 64 * (j))
#define XB_XGEN(j)  (2304 + 64 * (j))
#define XB_TOP      3328
#define XB_TOPGEN   3392
#define XB_SPIN_CAP (1u << 20)
#define LAS __attribute__((address_space(3)))
__device__ __forceinline__ unsigned xb_ld(unsigned* p)              { return __hip_atomic_load(p, __ATOMIC_RELAXED, __HIP_MEMORY_SCOPE_AGENT); }
__device__ __forceinline__ unsigned xb_add(unsigned* p, unsigned v) { return __hip_atomic_fetch_add(p, v, __ATOMIC_RELAXED, __HIP_MEMORY_SCOPE_AGENT); }
__device__ __forceinline__ unsigned xb_xcc_id() { return (unsigned)__builtin_amdgcn_s_getreg((3 << 11) | 20) & 0xFu; }
#define XB_SPIN(cond, bar) do { unsigned _sp = 0; while (cond) { __builtin_amdgcn_s_sleep(1); \
    if ((++_sp & 255u) == 0u) { if (xb_ld(&(bar)[XB_TMO])) break; if (_sp > XB_SPIN_CAP) { atomicAdd(&(bar)[XB_TMO], 1u); break; } } } } while (0)
struct XcdBarrier { unsigned* bar; unsigned x; volatile LAS unsigned* st; };
__device__ __forceinline__ XcdBarrier xcd_barrier_post(unsigned* bar, volatile LAS unsigned* st) {
  XcdBarrier b; b.bar = bar; b.x = xb_xcc_id(); b.st = st;
  if (threadIdx.x == 0) (void)xb_add(&bar[XB_XCNT(b.x)], 1u);
  return b;
}
__device__ __forceinline__ void xcd_barrier_complete(unsigned* bar, unsigned x, unsigned& nloc, unsigned& nx) {
  const unsigned G = gridDim.x;
  unsigned sum, cnt, mine, sp = 0u;
  for (;;) {
    sum = 0u; cnt = 0u; mine = 0u;
#pragma unroll
    for (unsigned j = 0; j < 16; ++j) { const unsigned c = xb_ld(&bar[XB_XCNT(j)]); sum += c; cnt += (c > 0u) ? 1u : 0u; mine = (j == x) ? c : mine; }
    if (sum == G) break;
    __builtin_amdgcn_s_sleep(1);
    if ((++sp & 255u) == 0u) { if (xb_ld(&bar[XB_TMO])) break; if (sp > XB_SPIN_CAP) { atomicAdd(&bar[XB_TMO], 1u); break; } }
  }
  nloc = mine > 0u ? mine : 1u; nx = cnt > 0u ? cnt : 1u;
}
__device__ __forceinline__ void xcd_barrier(const XcdBarrier& b) {
  asm volatile("s_waitcnt vmcnt(0)" ::: "memory");
  __syncthreads();
  if (threadIdx.x == 0) {
    unsigned* bar = b.bar;
    __builtin_amdgcn_s_waitcnt(0);
    unsigned nloc = b.st[0], nx = b.st[1];
    if (nloc == 0u) { xcd_barrier_complete(bar, b.x, nloc, nx); b.st[0] = nloc; b.st[1] = nx; }
    const unsigned old = xb_add(&bar[XB_XSUB(b.x)], 1u);
    const unsigned gen = old / nloc;
    if (old + 1u == (gen + 1u) * nloc) {
      __builtin_amdgcn_fence(__ATOMIC_RELEASE, "agent");
      asm volatile("s_waitcnt vmcnt(0)" ::: "memory");
      const unsigned og = xb_add(&bar[XB_TOP], 1u);
      const unsigned tg = og / nx;
      if (og + 1u == (tg + 1u) * nx) xb_add(&bar[XB_TOPGEN], 1u);
      else XB_SPIN(xb_ld(&bar[XB_TOPGEN]) == tg, bar);
      __builtin_amdgcn_fence(__ATOMIC_ACQUIRE, "agent");
      xb_add(&bar[XB_XGEN(b.x)], 1u);
      asm volatile("s_waitcnt vmcnt(0)" ::: "memory");
    } else {
      XB_SPIN(xb_ld(&bar[XB_XGEN(b.x)]) == gen, bar);
      __builtin_amdgcn_fence(__ATOMIC_ACQUIRE, "agent");
      asm volatile("s_waitcnt vmcnt(0)" ::: "memory");
    }
  }
  __syncthreads();
}
__global__ void __launch_bounds__(256, 2) fwd_mega(Params p) {
  extern __shared__ __attribute__((aligned(16))) unsigned char lds[];
  cg::grid_group grid = cg::this_grid();
  if (p.ph_lo < 0) grid.sync();
  volatile LAS unsigned* xb_st = (volatile LAS unsigned*)(LAS unsigned char*)(lds + LDS_BYTES - 16);
  if (threadIdx.x == 0) { xb_st[0] = 0u; xb_st[1] = 0u; }
  __syncthreads();
  const XcdBarrier xbar = xcd_barrier_post((unsigned*)(p.ws + WS_XBAR), xb_st);
  for (int ph = p.ph_lo; ph < p.ph_hi; ++ph) {
    if (ph == 0) {
      phase_prologue(p, lds);
    } else {
      const int l = (ph - 1) / 9, sub = (ph - 1) % 9;
      if (sub == 0) { phase_inproj(p, l, lds); }
      else if (sub == 1) {
        for (int it = blockIdx.x; it < 1536; it += gridDim.x) { if (it < 512) sgu_item(p, l, it, lds); else gla_passA_item(p, l, it - 512, lds); }
      }
      else if (sub == 2) { for (int it = blockIdx.x; it < 1024; it += gridDim.x) scan_item(p, it); }
      else if (sub == 3) { for (int it = blockIdx.x; it < 1024; it += gridDim.x) gla_passC_item(p, l, it, lds); }
      else if (sub == 4) { phase_outproj(p, l, lds); }
      else if (sub == 5) { phase_ln1(p, l); }
      else if (sub == 6) { phase_q(p, l, lds, (u16*)(p.ws + WS_QG)); }
      else if (sub == 7) { phase_route(p, l, lds, (const u16*)(p.ws + WS_QG)); }
      else { phase_expert(p, l, lds, l == NL - 1); }
    }
    if (ph + 1 < p.ph_hi) xcd_barrier(xbar);
  }
}

extern "C" void kernel_launch(void* const* d_in, const int* in_sizes, int n_in,
                              void* d_out, int out_size, void* d_ws, size_t ws_size,
                              hipStream_t stream) {
  static int grid_blocks = 0;
  if (!grid_blocks) {
    if (n_in != 21 || out_size != T_TOK * DM || ws_size < WS_END) {
      fprintf(stderr, "kernel_launch: unexpected shapes n_in=%d out=%d ws=%zu (need %zu)\n", n_in, out_size, ws_size, (size_t)WS_END);
      grid_blocks = -1; return;
    }
    int dev = 0, cus = 0, per_cu = 0;
    (void)hipGetDevice(&dev);
    (void)hipDeviceGetAttribute(&cus, hipDeviceAttributeMultiprocessorCount, dev);
    (void)hipFuncSetAttribute((const void*)fwd_mega, hipFuncAttributeMaxDynamicSharedMemorySize, LDS_BYTES);
    (void)hipOccupancyMaxActiveBlocksPerMultiprocessor(&per_cu, (const void*)fwd_mega, 256, LDS_BYTES);
    if (per_cu < 1) per_cu = 1;
    if (per_cu > 2) per_cu = 2;
    grid_blocks = cus * per_cu;
    fprintf(stderr, "kernel_launch: grid %d (cus %d x %d)\n", grid_blocks, cus, per_cu);
  }
  if (grid_blocks < 0) return;
  Params p{};
  for (int i = 0; i < 21; ++i) p.in[i] = (const float*)d_in[i];
  p.out = (float*)d_out; p.ws = (unsigned char*)d_ws; p.ph_lo = 0; p.ph_hi = NPHASE;
  (void)hipMemsetAsync((unsigned char*)d_ws + WS_BAR, 0, 16384, stream);
  void* args[] = {&p};
  hipError_t e = hipLaunchCooperativeKernel((void*)fwd_mega, dim3(grid_blocks), dim3(256), args, LDS_BYTES, stream);
  if (e != hipSuccess) fprintf(stderr, "cooperative launch failed: %s (grid %d)\n", hipGetErrorString(e), grid_blocks);
}
```

```cpp
#include <hip/hip_runtime.h>
#include <hip/hip_cooperative_groups.h>
#include <cstdio>
namespace cg = cooperative_groups;

typedef unsigned short u16;
using bf16x8 = __attribute__((ext_vector_type(8))) short;
using f32x4  = __attribute__((ext_vector_type(4))) float;
using u32x4  = __attribute__((ext_vector_type(4))) unsigned;
typedef __bf16 bf16x2_t __attribute__((ext_vector_type(2)));

constexpr int T_TOK = 16384;
constexpr int DM = 1024;
constexpr int INC = 2576;
constexpr int INCP = 2688;
constexpr int PLD = 2688;
constexpr int NL = 2;
constexpr int NEXP = 16384;
constexpr float LN_EPS = 1e-5f;
constexpr float ALPHA = 1.4142135623730951f;
constexpr int C_Q = 0, C_K = 256, C_V = 512, C_R = 1024, C_A = 1536, C_SU = 1552, C_SV = 2064;

constexpr size_t AL(size_t x) { return (x + 255) & ~(size_t)255; }
constexpr size_t WS_WIN  = 0;
constexpr size_t WS_WOUT = WS_WIN  + AL((size_t)NL * INCP * DM * 2);
constexpr size_t WS_WQ   = WS_WOUT + AL((size_t)NL * DM * DM * 2);
constexpr size_t WS_K1   = WS_WQ   + AL((size_t)NL * 2048 * DM * 2);
constexpr size_t WS_K2   = WS_K1   + AL((size_t)NL * 128 * 128 * 2);
constexpr size_t WS_SGUW = WS_K2   + AL((size_t)NL * 128 * 128 * 2);
constexpr size_t WS_UB   = WS_SGUW + AL((size_t)NL * 4 * 128 * 128 * 2);
constexpr size_t WS_VB   = WS_UB   + AL((size_t)NL * NEXP * DM * 2);
constexpr size_t WS_H    = WS_VB   + AL((size_t)NL * NEXP * DM * 2);
constexpr size_t WS_HB   = WS_H    + AL((size_t)T_TOK * DM * 4);
constexpr size_t WS_P    = WS_HB   + AL((size_t)T_TOK * DM * 2);
constexpr size_t WS_MC   = WS_P    + AL((size_t)T_TOK * PLD * 2);
constexpr size_t WS_KC   = WS_MC   + AL((size_t)T_TOK * DM * 2);
constexpr size_t WS_ST   = WS_KC   + AL((size_t)32 * 32 * 64 * 128 * 4);
constexpr size_t WS_DEC  = WS_ST   + AL((size_t)32 * 32 * 64 * 128 * 2);
constexpr size_t WS_EIDX = WS_DEC  + AL((size_t)32 * 32 * 64 * 4);
constexpr size_t WS_GATE = WS_EIDX + AL((size_t)T_TOK * 128 * 4);
constexpr size_t WS_QG   = WS_GATE + AL((size_t)T_TOK * 128 * 4);
constexpr size_t WS_BAR  = WS_QG + AL((size_t)T_TOK * 2048 * 2);
constexpr size_t WS_XBAR = WS_BAR + 256;
constexpr size_t WS_SU   = WS_XBAR + 16384 - 256;
constexpr size_t WS_SV   = WS_SU + (size_t)NL * NEXP * 4;
constexpr size_t WS_END  = WS_SV + (size_t)NL * NEXP * 4;

constexpr size_t WS_QDKD = WS_UB + ((size_t)40 << 20);
constexpr int LDS_BYTES = 77824;
constexpr int NPHASE = 1 + NL * 9;

struct Params {
  const float* in[21];
  float* out; unsigned char* ws; int ph_lo, ph_hi;
};
enum { I_X = 0, I_LNIG, I_LNIB, I_WIN, I_WGU, I_BG, I_GNG, I_SLG, I_SLB, I_SW, I_SB, I_WOUT, I_L1G, I_L1B, I_WQ, I_K1, I_K2, I_U, I_V, I_L2G, I_L2B };

__device__ __forceinline__ int ltid() { int t = threadIdx.x; asm volatile("" : "+v"(t)); return t; }
__device__ __forceinline__ unsigned cvtpk(float lo, float hi) { bf16x2_t v; v[0] = (__bf16)lo; v[1] = (__bf16)hi; return __builtin_bit_cast(unsigned, v); }
__device__ __forceinline__ u16 f2bf(float f) { return __builtin_bit_cast(u16, (__bf16)f); }
__device__ __forceinline__ float bf2f(u16 h) { return __uint_as_float(((unsigned)h) << 16); }
__device__ __forceinline__ float bflo(unsigned w) { return __uint_as_float(w << 16); }
__device__ __forceinline__ float bfhi(unsigned w) { return __uint_as_float(w & 0xffff0000u); }
__device__ __forceinline__ float gelu_f(float x) { return 0.5f * x * (1.f + erff(x * 0.70710678118654752f)); }
__device__ __forceinline__ float logsig(float x) { return fminf(x, 0.f) - log1pf(__expf(-fabsf(x))); }
__device__ __forceinline__ float wave_sum(float v) {
#pragma unroll
  for (int o = 32; o; o >>= 1) v += __shfl_xor(v, o);
  return v;
}
__device__ __forceinline__ float dot2(unsigned w, unsigned x, float acc) {
  return __builtin_amdgcn_fdot2_f32_bf16(__builtin_bit_cast(bf16x2_t, w), __builtin_bit_cast(bf16x2_t, x), acc, false);
}
__device__ __forceinline__ unsigned fkey(float f) { unsigned u = __float_as_uint(f); return u ^ ((u >> 31) ? 0xffffffffu : 0x80000000u); }
__device__ __forceinline__ float funkey(unsigned k) { unsigned u = k ^ ((k >> 31) ? 0x80000000u : 0xffffffffu); return __uint_as_float(u); }

#define GLD_B128(dst, ptr) dst = *(const u32x4*)(ptr)
#define GLD_B32(dst, ptr)  dst = *(const unsigned*)(ptr)
#define VM_WAIT0() asm volatile("s_waitcnt vmcnt(0)" ::: "memory")
__device__ __forceinline__ void unpack8(const u32x4& w, float (&f)[8]) {
  f[0] = bflo(w.x); f[1] = bfhi(w.x); f[2] = bflo(w.y); f[3] = bfhi(w.y); f[4] = bflo(w.z); f[5] = bfhi(w.z); f[6] = bflo(w.w); f[7] = bfhi(w.w);
}
__device__ __forceinline__ void ln_row(float (&y)[16], const float* __restrict__ g, const float* __restrict__ b, int lane,
                                       float* __restrict__ outf, u16* __restrict__ outb) {
  float s = 0.f;
#pragma unroll
  for (int i = 0; i < 16; ++i) s += y[i];
  const float mean = wave_sum(s) * (1.f / 1024.f);
  float q = 0.f;
#pragma unroll
  for (int i = 0; i < 16; ++i) { y[i] -= mean; q += y[i] * y[i]; }
  const float rstd = rsqrtf(wave_sum(q) * (1.f / 1024.f) + LN_EPS);
#pragma unroll
  for (int hseg = 0; hseg < 2; ++hseg) {
    const int c0 = hseg * 512 + lane * 8;
    const float4 g0 = *(const float4*)(g + c0), g1 = *(const float4*)(g + c0 + 4);
    const float4 b0 = *(const float4*)(b + c0), b1 = *(const float4*)(b + c0 + 4);
    float4 o0, o1;
    o0.x = y[hseg * 8 + 0] * rstd * g0.x + b0.x; o0.y = y[hseg * 8 + 1] * rstd * g0.y + b0.y;
    o0.z = y[hseg * 8 + 2] * rstd * g0.z + b0.z; o0.w = y[hseg * 8 + 3] * rstd * g0.w + b0.w;
    o1.x = y[hseg * 8 + 4] * rstd * g1.x + b1.x; o1.y = y[hseg * 8 + 5] * rstd * g1.y + b1.y;
    o1.z = y[hseg * 8 + 6] * rstd * g1.z + b1.z; o1.w = y[hseg * 8 + 7] * rstd * g1.w + b1.w;
    *(float4*)(outf + c0) = o0; *(float4*)(outf + c0 + 4) = o1;
    if (outb) {
      uint4 w; w.x = cvtpk(o0.x, o0.y); w.y = cvtpk(o0.z, o0.w); w.z = cvtpk(o1.x, o1.y); w.w = cvtpk(o1.z, o1.w);
      *(uint4*)(outb + c0) = w;
    }
  }
}
__device__ __forceinline__ void load_row16(const float* __restrict__ src, int lane, float (&y)[16]) {
#pragma unroll
  for (int hseg = 0; hseg < 2; ++hseg) {
    const float4 a = *(const float4*)(src + hseg * 512 + lane * 8), b = *(const float4*)(src + hseg * 512 + lane * 8 + 4);
    y[hseg * 8 + 0] = a.x; y[hseg * 8 + 1] = a.y; y[hseg * 8 + 2] = a.z; y[hseg * 8 + 3] = a.w;
    y[hseg * 8 + 4] = b.x; y[hseg * 8 + 5] = b.y; y[hseg * 8 + 6] = b.z; y[hseg * 8 + 7] = b.w;
  }
}

template <int BM, int BN, int BK, class Epi>
__device__ __forceinline__ void gemm_tile(const u16* __restrict__ A, const u16* __restrict__ B, const int K,
                                          const int m0, const int n0, unsigned char* lds, Epi& epi) {
  constexpr int LDK = BK;
  constexpr int MT = BM / 32, NT = BN / 32;
  constexpr int CPR = BK / 8;
  constexpr int A_CH = BM * CPR / 256, B_CH = BN * CPR / 256;
  constexpr int STAGE = (BM + BN) * LDK * 2;
  const int tid = ltid(), lane = tid & 63, wave = tid >> 6;
  const int wm = wave >> 1, wn = wave & 1;
  const int lr = lane & 15, lq = lane >> 4;
  f32x4 acc[MT][NT];
#pragma unroll
  for (int i = 0; i < MT; ++i)
#pragma unroll
    for (int j = 0; j < NT; ++j) acc[i][j] = (f32x4){0.f, 0.f, 0.f, 0.f};
  u32x4 ra[2][A_CH], rb[2][B_CH];
  const int KT = K / BK;
#define GT_ISSUE(set, tile) do { const int k0_ = (((tile) < KT) ? (tile) : (KT - 1)) * BK; \
    _Pragma("unroll") for (int i = 0; i < A_CH; ++i) { const int c = tid + i * 256, row = c / CPR, kc = c % CPR; const u16* gp = A + (size_t)(m0 + row) * K + k0_ + kc * 8; \
      asm volatile("global_load_dwordx4 %0, %1, off" : "=&v"(ra[set][i]) : "v"(gp) : "memory"); } \
    _Pragma("unroll") for (int i = 0; i < B_CH; ++i) { const int c = tid + i * 256, row = c / CPR, kc = c % CPR; const u16* gp = B + (size_t)(n0 + row) * K + k0_ + kc * 8; \
      asm volatile("global_load_dwordx4 %0, %1, off" : "=&v"(rb[set][i]) : "v"(gp) : "memory"); } } while (0)
#define GT_STORE(set, stage) do { u16* dA = (u16*)(lds + (stage) * STAGE); u16* dB = dA + BM * LDK; \
    _Pragma("unroll") for (int i = 0; i < A_CH; ++i) { const int c = tid + i * 256, row = c / CPR, kc = c % CPR; *(u32x4*)(dA + row * LDK + ((kc ^ (row & 7)) * 8)) = ra[set][i]; } \
    _Pragma("unroll") for (int i = 0; i < B_CH; ++i) { const int c = tid + i * 256, row = c / CPR, kc = c % CPR; *(u32x4*)(dB + row * LDK + ((kc ^ (row & 7)) * 8)) = rb[set][i]; } } while (0)
#define GT_COMPUTE(stage) do { const u16* sA = (const u16*)(lds + (stage) * STAGE); const u16* sB = sA + BM * LDK; \
    _Pragma("unroll") for (int ks = 0; ks < BK / 32; ++ks) { bf16x8 af[MT], bfr[NT]; \
      _Pragma("unroll") for (int i = 0; i < MT; ++i) af[i] = *(const bf16x8*)(sA + (wm * (BM / 2) + i * 16 + lr) * LDK + (((ks * 4 + lq) ^ (lr & 7)) * 8)); \
      _Pragma("unroll") for (int j = 0; j < NT; ++j) bfr[j] = *(const bf16x8*)(sB + (wn * (BN / 2) + j * 16 + lr) * LDK + (((ks * 4 + lq) ^ (lr & 7)) * 8)); \
      _Pragma("unroll") for (int i = 0; i < MT; ++i) _Pragma("unroll") for (int j = 0; j < NT; ++j) acc[i][j] = __builtin_amdgcn_mfma_f32_16x16x32_bf16(af[i], bfr[j], acc[i][j], 0, 0, 0); } } while (0)
  GT_ISSUE(0, 0);
  asm volatile("s_waitcnt vmcnt(0)" ::: "memory");
  GT_STORE(0, 0);
  GT_ISSUE(1, 1);
  __syncthreads();
#pragma unroll 1
  for (int kt = 0; kt < KT; kt += 2) {
    const bool m2 = (kt + 2 < KT);
    if (m2) GT_ISSUE(0, kt + 2);
    __builtin_amdgcn_sched_barrier(0);
    GT_COMPUTE(0);
    __builtin_amdgcn_sched_barrier(0);
    if (m2) asm volatile("s_waitcnt vmcnt(8)" ::: "memory"); else asm volatile("s_waitcnt vmcnt(0)" ::: "memory");
    GT_STORE(1, 1);
    __syncthreads();
    if (m2) GT_ISSUE(1, kt + 3);
    __builtin_amdgcn_sched_barrier(0);
    GT_COMPUTE(1);
    __builtin_amdgcn_sched_barrier(0);
    if (m2) { asm volatile("s_waitcnt vmcnt(8)" ::: "memory"); GT_STORE(0, 0); }
    __syncthreads();
  }
#undef GT_ISSUE
#undef GT_STORE
#undef GT_COMPUTE
  {
    int slot = 0;
#pragma unroll
    for (int i = 0; i < MT; ++i)
#pragma unroll
      for (int j = 0; j < NT; ++j)
#pragma unroll
        for (int r = 0; r < 4; ++r) epi.pre(wm * (BM / 2) + i * 16 + lq * 4 + r, wn * (BN / 2) + j * 16 + lr, slot++);
    slot = 0;
#pragma unroll
    for (int i = 0; i < MT; ++i)
#pragma unroll
      for (int j = 0; j < NT; ++j)
#pragma unroll
        for (int r = 0; r < 4; ++r)
          epi(wm * (BM / 2) + i * 16 + lq * 4 + r, wn * (BN / 2) + j * 16 + lr, acc[i][j][r], slot++);
  }
}

__device__ __forceinline__ void transpose_tile(const float* __restrict__ src, int Ksrc, int Nsrc, u16* __restrict__ dst, int kt, int nt, float* tl) {
  const int tid = ltid();
  const int k0 = kt * 64, n0 = nt * 64;
  u32x4 r[4];
#pragma unroll
  for (int m = 0; m < 4; ++m) {
    const int i = tid + m * 256, kk = i >> 4, n4 = (i & 15) * 4;
    const int nn = (n0 + n4 < Nsrc) ? (n0 + n4) : 0;
    const float* gp = src + (size_t)(k0 + kk) * Nsrc + nn;
    GLD_B128(r[m], gp);
  }
  VM_WAIT0();
#pragma unroll
  for (int m = 0; m < 4; ++m) {
    const int i = tid + m * 256, kk = i >> 4, n4 = (i & 15) * 4;
    const bool ok = (n0 + n4 < Nsrc);
    tl[kk * 65 + n4 + 0] = ok ? __uint_as_float(r[m].x) : 0.f; tl[kk * 65 + n4 + 1] = ok ? __uint_as_float(r[m].y) : 0.f;
    tl[kk * 65 + n4 + 2] = ok ? __uint_as_float(r[m].z) : 0.f; tl[kk * 65 + n4 + 3] = ok ? __uint_as_float(r[m].w) : 0.f;
  }
  __syncthreads();
  for (int i = tid; i < 2048; i += 256) {
    const int nn = i >> 5, kp = i & 31;
    const unsigned w = cvtpk(tl[(2 * kp) * 65 + nn], tl[(2 * kp + 1) * 65 + nn]);
    *(unsigned*)(dst + (size_t)(n0 + nn) * Ksrc + k0 + 2 * kp) = w;
  }
  __syncthreads();
}
__device__ __forceinline__ void convert8(const float* __restrict__ src, u16* __restrict__ dst, size_t n8, size_t gtid, size_t gn) {
  for (size_t i = gtid; i < n8; i += gn) {
    const float4 a = *(const float4*)(src + i * 8), b = *(const float4*)(src + i * 8 + 4);
    uint4 w; w.x = cvtpk(a.x, a.y); w.y = cvtpk(a.z, a.w); w.z = cvtpk(b.x, b.y); w.w = cvtpk(b.z, b.w);
    *(uint4*)(dst + i * 8) = w;
  }
}
__device__ __forceinline__ void phase_prologue(const Params& p, unsigned char* lds) {
  unsigned char* ws = p.ws;
  const int tid = ltid(), lane = tid & 63, wave = tid >> 6;
  const int nb = gridDim.x, bid = blockIdx.x;
  float* tl = (float*)lds;
  constexpr int PER_L = 672 + 256 + 512;
  for (int it = bid; it < NL * PER_L; it += nb) {
    const int l = it / PER_L; int r = it % PER_L;
    if (r < 672) { transpose_tile(p.in[I_WIN] + (size_t)l * DM * INC, DM, INC, (u16*)(ws + WS_WIN) + (size_t)l * INCP * DM, r / 42, r % 42, tl); }
    else if (r < 928) { r -= 672; transpose_tile(p.in[I_WOUT] + (size_t)l * DM * DM, DM, DM, (u16*)(ws + WS_WOUT) + (size_t)l * DM * DM, r / 16, r % 16, tl); }
    else { r -= 928; transpose_tile(p.in[I_WQ] + (size_t)l * DM * 2048, DM, 2048, (u16*)(ws + WS_WQ) + (size_t)l * 2048 * DM, r / 32, r % 32, tl); }
  }
  const size_t gtid = (size_t)bid * 256 + tid, gn = (size_t)nb * 256;
  for (int tb = 0; tb < 2 * NL; ++tb) {
    const float* src = p.in[(tb & 1) ? I_V : I_U] + (size_t)(tb >> 1) * NEXP * DM;
    unsigned char* dst = ws + ((tb & 1) ? WS_VB : WS_UB) + (size_t)(tb >> 1) * NEXP * DM;
    float* sdst = (float*)(ws + ((tb & 1) ? WS_SV : WS_SU)) + (size_t)(tb >> 1) * NEXP;
    for (int row0 = (bid * 4 + wave) * 4; row0 < NEXP; row0 += nb * 16) {
      float4 v[4][4];
#pragma unroll
      for (int r = 0; r < 4; ++r)
#pragma unroll
        for (int q = 0; q < 4; ++q) v[r][q] = *(const float4*)(src + (size_t)(row0 + r) * DM + lane * 16 + q * 4);
#pragma unroll
      for (int r = 0; r < 4; ++r) {
        float m = 0.f;
#pragma unroll
        for (int q = 0; q < 4; ++q) m = fmaxf(m, fmaxf(fmaxf(fabsf(v[r][q].x), fabsf(v[r][q].y)), fmaxf(fabsf(v[r][q].z), fabsf(v[r][q].w))));
#pragma unroll
        for (int o = 32; o; o >>= 1) m = fmaxf(m, __shfl_xor(m, o));
        m = fmaxf(m, 1e-30f);
        const float sc = 240.f / m;
        uint4 w; int t0;
        t0 = 0; t0 = __builtin_amdgcn_cvt_pk_fp8_f32(v[r][0].x * sc, v[r][0].y * sc, t0, false); t0 = __builtin_amdgcn_cvt_pk_fp8_f32(v[r][0].z * sc, v[r][0].w * sc, t0, true); w.x = (unsigned)t0;
        t0 = 0; t0 = __builtin_amdgcn_cvt_pk_fp8_f32(v[r][1].x * sc, v[r][1].y * sc, t0, false); t0 = __builtin_amdgcn_cvt_pk_fp8_f32(v[r][1].z * sc, v[r][1].w * sc, t0, true); w.y = (unsigned)t0;
        t0 = 0; t0 = __builtin_amdgcn_cvt_pk_fp8_f32(v[r][2].x * sc, v[r][2].y * sc, t0, false); t0 = __builtin_amdgcn_cvt_pk_fp8_f32(v[r][2].z * sc, v[r][2].w * sc, t0, true); w.z = (unsigned)t0;
        t0 = 0; t0 = __builtin_amdgcn_cvt_pk_fp8_f32(v[r][3].x * sc, v[r][3].y * sc, t0, false); t0 = __builtin_amdgcn_cvt_pk_fp8_f32(v[r][3].z * sc, v[r][3].w * sc, t0, true); w.w = (unsigned)t0;
        *(uint4*)(dst + (size_t)(row0 + r) * DM + lane * 16) = w;
        if (lane == 0) sdst[row0 + r] = m * (1.f / 240.f);
      }
    }
  }
  convert8(p.in[I_K1], (u16*)(ws + WS_K1), (size_t)NL * 128 * 128 / 8, gtid, gn);
  convert8(p.in[I_K2], (u16*)(ws + WS_K2), (size_t)NL * 128 * 128 / 8, gtid, gn);
  for (size_t i = gtid; i < (size_t)NL * 4 * 128 * 128; i += gn) {
    const int s = (int)(i & 127), t = (int)((i >> 7) & 127);
    const float v = ((s >> 6) <= (t >> 6)) ? p.in[I_SW][i] : 0.f;
    ((u16*)(ws + WS_SGUW))[i] = f2bf(v);
  }
  float* H = (float*)(ws + WS_H); u16* HB = (u16*)(ws + WS_HB);
  for (int row = bid * 4 + wave; row < T_TOK; row += nb * 4) {
    float y[16];
    load_row16(p.in[I_X] + (size_t)row * DM, lane, y);
    ln_row(y, p.in[I_LNIG], p.in[I_LNIB], lane, H + (size_t)row * DM, HB + (size_t)row * DM);
  }
}

template <int NT>
__device__ __forceinline__ bool xcd_tile(int j, int& mb, int& nb) {
  const int xcd = blockIdx.x & 7;
  const int grp = j / (8 * NT), r = j % (8 * NT);
  mb = xcd * 16 + grp * 8 + (r & 7); nb = r >> 3;
  return grp < 2;
}
struct EpiInproj {
  u16* P; int m0, n0;
  __device__ __forceinline__ void pre(int, int, int) {}
  __device__ __forceinline__ void operator()(int r, int c, float v, int) const {
    const int col = n0 + c;
    if (col < INC) {
      if (col < 256) v *= 0.125f;
      else if (col >= C_SU) v = gelu_f(v);
      P[(size_t)(m0 + r) * PLD + col] = f2bf(v);
    }
  }
};
__device__ __forceinline__ void phase_inproj(const Params& p, int l, unsigned char* lds) {
  const u16* A = (const u16*)(p.ws + WS_HB);
  const u16* B = (const u16*)(p.ws + WS_WIN) + (size_t)l * INCP * DM;
  u16* P = (u16*)(p.ws + WS_P);
  constexpr int NB_N = INCP / 128;
  for (int j = blockIdx.x >> 3; ; j += gridDim.x >> 3) {
    int mb, nbk; if (!xcd_tile<NB_N>(j, mb, nbk)) break;
    EpiInproj e{P, mb * 128, nbk * 128};
    gemm_tile<128, 128, 64>(A, B, DM, mb * 128, nbk * 128, lds, e);
  }
}

typedef short v4i16_t __attribute__((ext_vector_type(4)));
__device__ __forceinline__ bf16x8 tr_bfrag(const u16* img, int ld, int k0, int n0, int lr, int lq) {
  const u16* a0 = img + (k0 + 8 * lq + (lr >> 2)) * ld + n0 + 4 * (lr & 3);
  const v4i16_t lo = __builtin_amdgcn_ds_read_tr16_b64_v4i16((__attribute__((address_space(3))) v4i16_t*)a0);
  const v4i16_t hi = __builtin_amdgcn_ds_read_tr16_b64_v4i16((__attribute__((address_space(3))) v4i16_t*)(a0 + 4 * ld));
  return __builtin_shufflevector(lo, hi, 0, 1, 2, 3, 4, 5, 6, 7);
}
__device__ __forceinline__ void gla_bcum(const u16* __restrict__ Pm, const float* __restrict__ wgu, const float* __restrict__ bg,
                                         int tok0, int h, float* bc, float* a_s, float* wg_s, float* tot) {
  const int tid = ltid();
  {
    const int t = tid >> 2, q = tid & 3, r = tid >> 4, k4 = (tid & 15) * 4;
    const uint2 aw = *(const uint2*)(Pm + (size_t)(tok0 + t) * PLD + C_A + q * 4);
    const float4 wv = *(const float4*)(wgu + r * 256 + h * 64 + k4);
    const float bgv = bg[h * 64 + (tid & 63)];
    a_s[t * 16 + q * 4 + 0] = bflo(aw.x); a_s[t * 16 + q * 4 + 1] = bfhi(aw.x); a_s[t * 16 + q * 4 + 2] = bflo(aw.y); a_s[t * 16 + q * 4 + 3] = bfhi(aw.y);
    wg_s[r * 64 + k4 + 0] = wv.x; wg_s[r * 64 + k4 + 1] = wv.y; wg_s[r * 64 + k4 + 2] = wv.z; wg_s[r * 64 + k4 + 3] = wv.w;
    if (tid < 64) wg_s[1024 + tid] = bgv;
  }
  __syncthreads();
  {
    const int k = tid & 63, qt = tid >> 6;
    float wcol[16];
#pragma unroll
    for (int r = 0; r < 16; ++r) wcol[r] = wg_s[r * 64 + k];
    const float bgk = wg_s[1024 + k];
    float lg[16];
    float c = 0.f;
#pragma unroll
    for (int j = 0; j < 16; ++j) {
      const float4* ap = (const float4*)(a_s + (qt * 16 + j) * 16);
      const float4 a0 = ap[0], a1 = ap[1], a2 = ap[2], a3 = ap[3];
      float sacc = bgk;
      sacc += a0.x * wcol[0]; sacc += a0.y * wcol[1]; sacc += a0.z * wcol[2]; sacc += a0.w * wcol[3];
      sacc += a1.x * wcol[4]; sacc += a1.y * wcol[5]; sacc += a1.z * wcol[6]; sacc += a1.w * wcol[7];
      sacc += a2.x * wcol[8]; sacc += a2.y * wcol[9]; sacc += a2.z * wcol[10]; sacc += a2.w * wcol[11];
      sacc += a3.x * wcol[12]; sacc += a3.y * wcol[13]; sacc += a3.z * wcol[14]; sacc += a3.w * wcol[15];
      c += logsig(sacc) * (1.f / 16.f);
      lg[j] = c;
    }
    tot[qt * 64 + k] = c;
    __syncthreads();
    float pre = 0.f;
    for (int q = 0; q < qt; ++q) pre += tot[q * 64 + k];
#pragma unroll
    for (int j = 0; j < 16; ++j) bc[(qt * 16 + j) * 65 + k] = lg[j] + pre;
  }
  __syncthreads();
}

__device__ __forceinline__ void gla_passA_item(const Params& p, int l, int item, unsigned char* lds) {
  const int tid = ltid(), lane = tid & 63, wave = tid >> 6, lr = lane & 15, lq = lane >> 4;
  const int bh = item >> 5, n = item & 31, b = bh >> 2, h = bh & 3;
  const int tok0 = b * 2048 + n * 64;
  const u16* Pm = (const u16*)(p.ws + WS_P);
  float* bc = (float*)lds;
  u16* kdT = (u16*)(lds + 16640);
  u16* vT = (u16*)(lds + 16640 + 9216);
  float* a_s = (float*)(lds + 16640 + 9216 + 18432);
  float* wg_s = a_s + 1024;
  float* tot = wg_s + 1088;
  gla_bcum(Pm, p.in[I_WGU] + (size_t)l * 16 * 256, p.in[I_BG] + (size_t)l * 256, tok0, h, bc, a_s, wg_s, tot);
  {
    u32x4 rk[2], rv[4], rq[2];
#pragma unroll
    for (int m = 0; m < 2; ++m) { const int i = tid + m * 256, s = i >> 3, k0 = (i & 7) * 8; const u16* gp = Pm + (size_t)(tok0 + s) * PLD + C_K + h * 64 + k0; GLD_B128(rk[m], gp); const u16* gq = gp - (C_K - C_Q); GLD_B128(rq[m], gq); }
#pragma unroll
    for (int m = 0; m < 4; ++m) { const int i = tid + m * 256, s = i >> 4, v0 = (i & 15) * 8; const u16* gp = Pm + (size_t)(tok0 + s) * PLD + C_V + h * 128 + v0; GLD_B128(rv[m], gp); }
    VM_WAIT0();
#pragma unroll
    for (int m = 0; m < 2; ++m) {
      const int i = tid + m * 256, s = i >> 3, k0 = (i & 7) * 8;
      float f[8]; unpack8(rk[m], f);
      float fq[8]; unpack8(rq[m], fq);
      unsigned wq[4], wk[4];
      {
        unsigned wl[4];
#pragma unroll
        for (int j = 0; j < 4; ++j)
          wl[j] = cvtpk(f[2 * j] * __expf(bc[63 * 65 + k0 + 2 * j] - bc[s * 65 + k0 + 2 * j]), f[2 * j + 1] * __expf(bc[63 * 65 + k0 + 2 * j + 1] - bc[s * 65 + k0 + 2 * j + 1]));
        *(uint4*)(kdT + s * 72 + k0) = make_uint4(wl[0], wl[1], wl[2], wl[3]);
      }
#pragma unroll
      for (int j = 0; j < 4; ++j) {
        const float b0 = bc[s * 65 + k0 + 2 * j], b1 = bc[s * 65 + k0 + 2 * j + 1];
        wq[j] = cvtpk(fq[2 * j] * __expf(b0), fq[2 * j + 1] * __expf(b1));
        wk[j] = cvtpk(f[2 * j] * __expf(-b0), f[2 * j + 1] * __expf(-b1));
      }
      u16* qdkd = (u16*)(p.ws + WS_QDKD) + (size_t)item * 2 * 4096;
      *(uint4*)(qdkd + s * 64 + k0) = make_uint4(wq[0], wq[1], wq[2], wq[3]);
      *(uint4*)(qdkd + 4096 + s * 64 + k0) = make_uint4(wk[0], wk[1], wk[2], wk[3]);
    }
#pragma unroll
    for (int m = 0; m < 4; ++m) {
      const int i = tid + m * 256, s = i >> 4, v0 = (i & 15) * 8;
      *(u32x4*)(vT + s * 136 + v0) = rv[m];
    }
  }
  __syncthreads();
  f32x4 acc[8];
#pragma unroll
  for (int j = 0; j < 8; ++j) acc[j] = (f32x4){0.f, 0.f, 0.f, 0.f};
#pragma unroll
  for (int ks = 0; ks < 2; ++ks) {
    const bf16x8 a = tr_bfrag(kdT, 72, ks * 32, wave * 16, lr, lq);
#pragma unroll
    for (int j = 0; j < 8; ++j) {
      const bf16x8 bb = tr_bfrag(vT, 136, ks * 32, j * 16, lr, lq);
      acc[j] = __builtin_amdgcn_mfma_f32_16x16x32_bf16(a, bb, acc[j], 0, 0, 0);
    }
  }
  float* KC = (float*)(p.ws + WS_KC) + (size_t)item * 64 * 128;
#pragma unroll
  for (int j = 0; j < 8; ++j)
#pragma unroll
    for (int r = 0; r < 4; ++r) KC[(wave * 16 + lq * 4 + r) * 128 + j * 16 + lr] = acc[j][r];
  if (tid < 64) ((float*)(p.ws + WS_DEC))[item * 64 + tid] = __expf(bc[63 * 65 + tid]);
  __syncthreads();
}

__device__ __forceinline__ void sgu_item(const Params& p, int l, int item, unsigned char* lds) {
  const int tid = ltid(), lane = tid & 63, wave = tid >> 6, lr = lane & 15, lq = lane >> 4;
  const int win = item >> 2, g = item & 3;
  const int tok0 = win * 128;
  const u16* Pm = (const u16*)(p.ws + WS_P);
  float* mean_s = (float*)lds; float* rstd_s = mean_s + 128;
  u16* vT = (u16*)(lds + 1024);
#pragma unroll 1
  for (int b8 = 0; b8 < 2; ++b8) {
    u32x4 rw[16];
#pragma unroll
    for (int i = 0; i < 16; ++i) { const int s = wave * 32 + b8 * 16 + i; const u16* gp = Pm + (size_t)(tok0 + s) * PLD + C_SV + lane * 8; GLD_B128(rw[i], gp); }
    VM_WAIT0();
#pragma unroll
    for (int i = 0; i < 16; ++i) {
      const int s = wave * 32 + b8 * 16 + i;
      float f[8]; unpack8(rw[i], f);
      const float sm = f[0] + f[1] + f[2] + f[3] + f[4] + f[5] + f[6] + f[7];
      const float mean = wave_sum(sm) * (1.f / 512.f);
      float sq = 0.f;
#pragma unroll
      for (int j = 0; j < 8; ++j) { const float d = f[j] - mean; sq += d * d; }
      const float var = wave_sum(sq) * (1.f / 512.f);
      if (lane == 0) { mean_s[s] = mean; rstd_s[s] = rsqrtf(var + LN_EPS); }
    }
  }
  __syncthreads();
  float bsv[8];
#pragma unroll
  for (int i = 0; i < 2; ++i)
#pragma unroll
    for (int r = 0; r < 4; ++r) bsv[i * 4 + r] = p.in[I_SB][((size_t)l * 4 + g) * 128 + wave * 32 + i * 16 + lq * 4 + r];
  u32x4 ru[8];
  {
    const int c0 = (tid & 15) * 8;
    const float* lng = p.in[I_SLG] + (size_t)l * 512 + g * 128 + c0;
    const float* lnb = p.in[I_SLB] + (size_t)l * 512 + g * 128 + c0;
    u32x4 rv[8];
#pragma unroll
    for (int m = 0; m < 8; ++m) { const int i = tid + m * 256, s = i >> 4; const u16* gv = Pm + (size_t)(tok0 + s) * PLD + C_SV + g * 128 + c0; const u16* gu = Pm + (size_t)(tok0 + s) * PLD + C_SU + g * 128 + c0; GLD_B128(rv[m], gv); GLD_B128(ru[m], gu); }
    const float4 ga = *(const float4*)(lng), gb = *(const float4*)(lng + 4), ba = *(const float4*)(lnb), bb = *(const float4*)(lnb + 4);
    const float gg[8] = {ga.x, ga.y, ga.z, ga.w, gb.x, gb.y, gb.z, gb.w}, bbv[8] = {ba.x, ba.y, ba.z, ba.w, bb.x, bb.y, bb.z, bb.w};
    VM_WAIT0();
#pragma unroll
    for (int m = 0; m < 8; ++m) {
      const int i = tid + m * 256, s = i >> 4;
      float f[8]; unpack8(rv[m], f);
      const float mu = mean_s[s], rs = rstd_s[s];
      unsigned wn[4];
#pragma unroll
      for (int j = 0; j < 4; ++j) wn[j] = cvtpk((f[2 * j] - mu) * rs * gg[2 * j] + bbv[2 * j], (f[2 * j + 1] - mu) * rs * gg[2 * j + 1] + bbv[2 * j + 1]);
      *(uint4*)(vT + s * 136 + c0) = make_uint4(wn[0], wn[1], wn[2], wn[3]);
    }
  }
  __syncthreads();
  const u16* W = (const u16*)(p.ws + WS_SGUW) + ((size_t)l * 4 + g) * 128 * 128;
  f32x4 acc[2][8];
#pragma unroll
  for (int i = 0; i < 2; ++i)
#pragma unroll
    for (int j = 0; j < 8; ++j) acc[i][j] = (f32x4){0.f, 0.f, 0.f, 0.f};
  const int nks = (wave < 2) ? 2 : 4;
  for (int ks = 0; ks < nks; ++ks) {
    bf16x8 a[2];
#pragma unroll
    for (int i = 0; i < 2; ++i) a[i] = *(const bf16x8*)(W + (size_t)(wave * 32 + i * 16 + lr) * 128 + ks * 32 + lq * 8);
#pragma unroll
    for (int j = 0; j < 8; ++j) {
      const bf16x8 bb = tr_bfrag(vT, 136, ks * 32, j * 16, lr, lq);
#pragma unroll
      for (int i = 0; i < 2; ++i) acc[i][j] = __builtin_amdgcn_mfma_f32_16x16x32_bf16(a[i], bb, acc[i][j], 0, 0, 0);
    }
  }
  const float* bs = p.in[I_SB] + ((size_t)l * 4 + g) * 128;
  u16* MC = (u16*)(p.ws + WS_MC);
  u16* uT = vT;
  __syncthreads();
#pragma unroll
  for (int m = 0; m < 8; ++m) { const int i = tid + m * 256, t = i >> 4, c0 = (i & 15) * 8; *(u32x4*)(uT + t * 136 + c0) = ru[m]; }
  __syncthreads();
#pragma unroll
  for (int i = 0; i < 2; ++i)
#pragma unroll
    for (int r = 0; r < 4; ++r) {
      const int t = wave * 32 + i * 16 + lq * 4 + r;
      const float bias = bsv[i * 4 + r];
#pragma unroll
      for (int j = 0; j < 8; ++j) {
        const int c = j * 16 + lr;
        const float u = bf2f(uT[t * 136 + c]);
        MC[(size_t)(tok0 + t) * DM + 512 + g * 128 + c] = f2bf((acc[i][j][r] + bias) * u);
      }
    }
  __syncthreads();
}

__device__ __forceinline__ void scan_item(const Params& p, int item) {
  const int e = item * 256 + ltid();
  const int bh = e >> 13, k = (e >> 7) & 63, v = e & 127;
  const float* KC = (const float*)(p.ws + WS_KC);
  const float* DEC = (const float*)(p.ws + WS_DEC);
  u16* ST = (u16*)(p.ws + WS_ST);
  float S = 0.f;
#pragma unroll 1
  for (int n8 = 0; n8 < 2; ++n8) {
    unsigned kc[16], dc[16];
#pragma unroll
    for (int j = 0; j < 16; ++j) {
      const int n = n8 * 16 + j;
      const float* gk = KC + ((size_t)(bh * 32 + n) * 64 + k) * 128 + v; const float* gd = DEC + (bh * 32 + n) * 64 + k;
      GLD_B32(kc[j], gk); GLD_B32(dc[j], gd);
    }
    VM_WAIT0();
#pragma unroll
    for (int j = 0; j < 16; ++j) {
      const int n = n8 * 16 + j;
      ST[((size_t)(bh * 32 + n) * 64 + k) * 128 + v] = f2bf(S);
      S = __uint_as_float(dc[j]) * S + __uint_as_float(kc[j]);
    }
  }
}

__device__ __forceinline__ void gla_passC_item(const Params& p, int l, int item, unsigned char* lds) {
  const int tid = ltid(), lane = tid & 63, wave = tid >> 6, lr = lane & 15, lq = lane >> 4;
  const int bh = item >> 5, n = item & 31, b = bh >> 2, h = bh & 3;
  const int tok0 = b * 2048 + n * 64;
  const u16* Pm = (const u16*)(p.ws + WS_P);
  u16* attn = (u16*)lds;
  u16* qd = (u16*)(lds + 16640);
  u16* kd = (u16*)(lds + 16640 + 9216);
  u16* vT = (u16*)(lds + 16640 + 18432);
  u16* stT = (u16*)(lds + 16640 + 36864);
  const u16* ST = (const u16*)(p.ws + WS_ST) + (size_t)item * 64 * 128;
  float gnv[8];
#pragma unroll
  for (int j = 0; j < 8; ++j) gnv[j] = p.in[I_GNG][(size_t)l * 128 + j * 16 + lr];
  u32x4 rr4[4];
  {
    u32x4 rq[2], rk[2], rv[4], rs[4];
    const u16* qdkd = (const u16*)(p.ws + WS_QDKD) + (size_t)item * 2 * 4096;
#pragma unroll
    for (int m = 0; m < 2; ++m) { const int i = tid + m * 256, t = i >> 3, k0 = (i & 7) * 8; const u16* gq = qdkd + t * 64 + k0; const u16* gk = gq + 4096; GLD_B128(rq[m], gq); GLD_B128(rk[m], gk); }
#pragma unroll
    for (int m = 0; m < 4; ++m) { const int i = tid + m * 256, s = i >> 4, v0 = (i & 15) * 8; const u16* gv = Pm + (size_t)(tok0 + s) * PLD + C_V + h * 128 + v0; const u16* gs = ST + s * 128 + v0; const u16* gr = Pm + (size_t)(tok0 + s) * PLD + C_R + h * 128 + v0;
      GLD_B128(rv[m], gv); GLD_B128(rs[m], gs); GLD_B128(rr4[m], gr); }
    VM_WAIT0();
#pragma unroll
    for (int m = 0; m < 2; ++m) {
      const int i = tid + m * 256, t = i >> 3, k0 = (i & 7) * 8;
      *(u32x4*)(qd + t * 72 + k0) = rq[m];
      *(u32x4*)(kd + t * 72 + k0) = rk[m];
    }
#pragma unroll
    for (int m = 0; m < 4; ++m) {
      const int i = tid + m * 256, s = i >> 4, v0 = (i & 15) * 8;
      *(u32x4*)(vT + s * 136 + v0) = rv[m];
      *(u32x4*)(stT + s * 136 + v0) = rs[m];
    }
  }
  __syncthreads();
  {
    f32x4 sa[4];
#pragma unroll
    for (int j = 0; j < 4; ++j) sa[j] = (f32x4){0.f, 0.f, 0.f, 0.f};
#pragma unroll
    for (int ks = 0; ks < 2; ++ks) {
      const bf16x8 a = *(const bf16x8*)(qd + (wave * 16 + lr) * 72 + ks * 32 + lq * 8);
#pragma unroll
      for (int j = 0; j < 4; ++j) {
        const bf16x8 bb = *(const bf16x8*)(kd + (j * 16 + lr) * 72 + ks * 32 + lq * 8);
        sa[j] = __builtin_amdgcn_mfma_f32_16x16x32_bf16(a, bb, sa[j], 0, 0, 0);
      }
    }
#pragma unroll
    for (int j = 0; j < 4; ++j)
#pragma unroll
      for (int r = 0; r < 4; ++r) {
        const int t = wave * 16 + lq * 4 + r, s = j * 16 + lr;
        attn[t * 72 + s] = f2bf((s <= t) ? sa[j][r] : 0.f);
      }
  }
  __syncthreads();
  f32x4 acc[8];
#pragma unroll
  for (int j = 0; j < 8; ++j) acc[j] = (f32x4){0.f, 0.f, 0.f, 0.f};
#pragma unroll
  for (int ks = 0; ks < 2; ++ks) {
    const bf16x8 a = *(const bf16x8*)(attn + (wave * 16 + lr) * 72 + ks * 32 + lq * 8);
#pragma unroll
    for (int j = 0; j < 8; ++j) {
      const bf16x8 bb = tr_bfrag(vT, 136, ks * 32, j * 16, lr, lq);
      acc[j] = __builtin_amdgcn_mfma_f32_16x16x32_bf16(a, bb, acc[j], 0, 0, 0);
    }
  }
#pragma unroll
  for (int ks = 0; ks < 2; ++ks) {
    const bf16x8 a = *(const bf16x8*)(qd + (wave * 16 + lr) * 72 + ks * 32 + lq * 8);
#pragma unroll
    for (int j = 0; j < 8; ++j) {
      const bf16x8 bb = tr_bfrag(stT, 136, ks * 32, j * 16, lr, lq);
      acc[j] = __builtin_amdgcn_mfma_f32_16x16x32_bf16(a, bb, acc[j], 0, 0, 0);
    }
  }
  const float* gn = p.in[I_GNG] + (size_t)l * 128;
  u16* MC = (u16*)(p.ws + WS_MC);
  u16* rT = vT;
  __syncthreads();
#pragma unroll
  for (int m = 0; m < 4; ++m) { const int i = tid + m * 256, t = i >> 4, v0 = (i & 15) * 8; *(u32x4*)(rT + t * 136 + v0) = rr4[m]; }
  __syncthreads();
#pragma unroll
  for (int r = 0; r < 4; ++r) {
    float ss = 0.f;
#pragma unroll
    for (int j = 0; j < 8; ++j) ss += acc[j][r] * acc[j][r];
    ss += __shfl_xor(ss, 1); ss += __shfl_xor(ss, 2); ss += __shfl_xor(ss, 4); ss += __shfl_xor(ss, 8);
    const float rinv = rsqrtf(ss * (1.f / 128.f) + LN_EPS);
    const int t = wave * 16 + lq * 4 + r;
#pragma unroll
    for (int j = 0; j < 8; ++j) {
      const int v = j * 16 + lr;
      const float rr = bf2f(rT[t * 136 + v]);
      const float sil = rr / (1.f + __expf(-rr));
      MC[(size_t)(tok0 + t) * DM + h * 128 + v] = f2bf(acc[j][r] * rinv * gnv[j] * sil);
    }
  }
  __syncthreads();
}

struct EpiOutproj {
  const float* H; float* O; int m0, n0; float hv[64];
  __device__ __forceinline__ void pre(int r, int c, int slot) { hv[slot] = H[(size_t)(m0 + r) * DM + n0 + c]; }
  __device__ __forceinline__ void operator()(int r, int c, float v, int slot) const {
    const size_t idx = (size_t)(m0 + r) * DM + n0 + c;
    O[idx] = ALPHA * hv[slot] + v;
  }
};
__device__ __forceinline__ void phase_outproj(const Params& p, int l, unsigned char* lds) {
  const u16* A = (const u16*)(p.ws + WS_MC);
  const u16* B = (const u16*)(p.ws + WS_WOUT) + (size_t)l * DM * DM;
  for (int j = blockIdx.x >> 3; ; j += gridDim.x >> 3) {
    int mb, nbk; if (!xcd_tile<8>(j, mb, nbk)) break;
    EpiOutproj e; e.H = (const float*)(p.ws + WS_H); e.O = p.out; e.m0 = mb * 128; e.n0 = nbk * 128;
    gemm_tile<128, 128, 64>(A, B, DM, mb * 128, nbk * 128, lds, e);
  }
}
__device__ __forceinline__ void phase_ln1(const Params& p, int l) {
  const int lane = ltid() & 63, wave = ltid() >> 6;
  float* H = (float*)(p.ws + WS_H); u16* HB = (u16*)(p.ws + WS_HB);
  for (int row = blockIdx.x * 4 + wave; row < T_TOK; row += gridDim.x * 4) {
    float y[16];
    load_row16(p.out + (size_t)row * DM, lane, y);
    ln_row(y, p.in[I_L1G] + (size_t)l * DM, p.in[I_L1B] + (size_t)l * DM, lane, H + (size_t)row * DM, HB + (size_t)row * DM);
  }
}

#define CE_DESC(a, b) { const unsigned hi_ = max(a, b), lo_ = min(a, b); a = hi_; b = lo_; }
template <int N>
__device__ __forceinline__ void bitonic_sort_desc(unsigned (&a)[N]) {
#pragma unroll
  for (int k = 2; k <= N; k <<= 1)
#pragma unroll
    for (int j = k >> 1; j > 0; j >>= 1)
#pragma unroll
      for (int i = 0; i < N; ++i) {
        const int l = i ^ j;
        if (l > i) {
          const unsigned hi = max(a[i], a[l]), lo = min(a[i], a[l]);
          if ((i & k) == 0) { a[i] = hi; a[l] = lo; } else { a[i] = lo; a[l] = hi; }
        }
      }
}
__device__ __forceinline__ void merge16_group4(unsigned (&a)[32]) {
#pragma unroll
  for (int step = 1; step <= 2; step <<= 1) {
    unsigned bq[16];
#pragma unroll
    for (int i = 0; i < 16; ++i) bq[i] = (unsigned)__shfl_xor((int)a[15 - i], step);
#pragma unroll
    for (int i = 0; i < 16; ++i) a[i] = max(a[i], bq[i]);
#pragma unroll
    for (int k = 8; k >= 1; k >>= 1)
#pragma unroll
      for (int i = 0; i < 16; ++i) if ((i & k) == 0) CE_DESC(a[i], a[i | k]);
  }
}
__device__ __forceinline__ void topk16_half(const float* sc_s, int t, int part, unsigned (&a)[32]) {
#pragma unroll
  for (int i = 0; i < 32; ++i) {
    const int nn = 4 * i + part;
    a[i] = (fkey(sc_s[t * 132 + nn]) & ~127u) | (unsigned)(127 - nn);
  }
  bitonic_sort_desc<32>(a);
  merge16_group4(a);
}
struct EpiQG {
  u16* Q; int m0, n0;
  __device__ __forceinline__ void pre(int, int, int) {}
  __device__ __forceinline__ void operator()(int r, int c, float v, int) const { Q[(size_t)(m0 + r) * 2048 + n0 + c] = f2bf(v); }
};
__device__ __forceinline__ void phase_q(const Params& p, int l, unsigned char* lds, u16* Qg) {
  const u16* A = (const u16*)(p.ws + WS_HB);
  const u16* B = (const u16*)(p.ws + WS_WQ) + (size_t)l * 2048 * DM;
  for (int j = blockIdx.x >> 3; ; j += gridDim.x >> 3) {
    int mb, nbk; if (!xcd_tile<16>(j, mb, nbk)) break;
    EpiQG e{Qg, mb * 128, nbk * 128};
    gemm_tile<128, 128, 64>(A, B, DM, mb * 128, nbk * 128, lds, e);
  }
}
__device__ __forceinline__ void phase_route(const Params& p, int l, unsigned char* lds, const u16* Qg) {
  const int tid = ltid(), lane = tid & 63, wave = tid >> 6, lr = lane & 15, lq = lane >> 4;
  u16* q_s = (u16*)lds;
  float* sc_s = (float*)(lds + 33792);
  u16* kb_s = (u16*)(lds + 33792);
  unsigned* key_s = (unsigned*)(lds + 68608);
  int* EIDX = (int*)(p.ws + WS_EIDX); float* GATE = (float*)(p.ws + WS_GATE);
  for (int it = blockIdx.x; it < (T_TOK / 64) * 8; it += gridDim.x) {
    const int mb = it >> 3, hd = it & 7;
    {
      u32x4 rq[8];
#pragma unroll
      for (int m = 0; m < 8; ++m) { const int i = tid + m * 256, r = i >> 5, c8 = i & 31; const u16* gp = Qg + (size_t)(mb * 64 + r) * 2048 + hd * 256 + c8 * 8; GLD_B128(rq[m], gp); }
      VM_WAIT0();
#pragma unroll
      for (int m = 0; m < 8; ++m) { const int i = tid + m * 256, r = i >> 5, c8 = i & 31; *(u32x4*)(q_s + r * 264 + c8 * 8) = rq[m]; }
    }
    __syncthreads();
    const int t = tid >> 2, part = tid & 3;
#pragma unroll 1
    for (int half = 0; half < 2; ++half) {
      const u16* Kb = (const u16*)(p.ws + (half ? WS_K2 : WS_K1)) + (size_t)l * 128 * 128;
      __syncthreads();
      {
        u32x4 rk[8];
#pragma unroll
        for (int m = 0; m < 8; ++m) { const int i = tid + m * 256, n = i >> 4, c8 = i & 15; rk[m] = *(const u32x4*)(Kb + (size_t)n * 128 + c8 * 8); }
#pragma unroll
        for (int m = 0; m < 8; ++m) { const int i = tid + m * 256, n = i >> 4, c8 = i & 15; *(u32x4*)(kb_s + n * 136 + c8 * 8) = rk[m]; }
      }
      __syncthreads();
      f32x4 sa[8];
#pragma unroll
      for (int j = 0; j < 8; ++j) sa[j] = (f32x4){0.f, 0.f, 0.f, 0.f};
#pragma unroll
      for (int ks = 0; ks < 4; ++ks) {
        const bf16x8 a = *(const bf16x8*)(q_s + (wave * 16 + lr) * 264 + half * 128 + ks * 32 + lq * 8);
#pragma unroll
        for (int j = 0; j < 8; ++j) {
          const bf16x8 bb = *(const bf16x8*)(kb_s + (j * 16 + lr) * 136 + ks * 32 + lq * 8);
          sa[j] = __builtin_amdgcn_mfma_f32_16x16x32_bf16(a, bb, sa[j], 0, 0, 0);
        }
      }
      __syncthreads();
#pragma unroll
      for (int j = 0; j < 8; ++j)
#pragma unroll
        for (int r = 0; r < 4; ++r) sc_s[(wave * 16 + lq * 4 + r) * 132 + j * 16 + lr] = sa[j][r];
      __syncthreads();
      unsigned a[32];
      topk16_half(sc_s, t, part, a);
      if (part == 0) {
#pragma unroll
        for (int w = 0; w < 4; ++w) *(uint4*)(key_s + t * 32 + half * 16 + 4 * w) = make_uint4(a[4 * w], a[4 * w + 1], a[4 * w + 2], a[4 * w + 3]);
      }
    }
    __syncthreads();
    {
      const unsigned* k1p = key_s + t * 32; const unsigned* k2p = k1p + 16;
      float v2[16];
#pragma unroll
      for (int j = 0; j < 16; ++j) v2[j] = funkey(k2p[j] & ~127u);
      unsigned c[32];
#pragma unroll
      for (int i = 0; i < 32; ++i) c[i] = 0u;
      {
        const int i0 = part; const float v1 = funkey(k1p[i0] & ~127u); const int nj = 16 / (i0 + 1);
#pragma unroll
        for (int j = 0; j < 16; ++j) c[j] = (j < nj) ? ((fkey(v1 + v2[j]) & ~255u) | (unsigned)(255 - (i0 * 16 + j))) : 0u;
      }
      {
        const int i1 = part + 4; const float v1 = funkey(k1p[i1] & ~127u); const int nj = 16 / (i1 + 1);
#pragma unroll
        for (int j = 0; j < 3; ++j) c[16 + j] = (j < nj) ? ((fkey(v1 + v2[j]) & ~255u) | (unsigned)(255 - (i1 * 16 + j))) : 0u;
      }
      { const int i2 = part + 8;  const float v1 = funkey(k1p[i2] & ~127u); c[19] = (fkey(v1 + v2[0]) & ~255u) | (unsigned)(255 - (i2 * 16)); }
      { const int i3 = part + 12; const float v1 = funkey(k1p[i3] & ~127u); c[20] = (fkey(v1 + v2[0]) & ~255u) | (unsigned)(255 - (i3 * 16)); }
      bitonic_sort_desc<32>(c);
      merge16_group4(c);
      const float m = funkey(c[0] & ~255u);
      float ex[16]; float ssum = 0.f;
#pragma unroll
      for (int r = 0; r < 16; ++r) { ex[r] = __expf(funkey(c[r] & ~255u) - m); ssum += ex[r]; }
      const float inv = 1.f / ssum;
      int ei4[4]; float g4[4];
#pragma unroll
      for (int w = 0; w < 4; ++w) {
        const unsigned ck = (part == 0) ? c[w] : (part == 1) ? c[4 + w] : (part == 2) ? c[8 + w] : c[12 + w];
        const float ev = (part == 0) ? ex[w] : (part == 1) ? ex[4 + w] : (part == 2) ? ex[8 + w] : ex[12 + w];
        const unsigned pos = 255u - (ck & 255u);
        const int i1 = 127 - (int)(k1p[pos >> 4] & 127u), i2 = 127 - (int)(k2p[pos & 15] & 127u);
        ei4[w] = i1 * 128 + i2; g4[w] = ev * inv;
      }
      const size_t base = ((size_t)hd * T_TOK + mb * 64 + t) * 16 + part * 4;
      *(int4*)(EIDX + base) = make_int4(ei4[0], ei4[1], ei4[2], ei4[3]);
      *(float4*)(GATE + base) = make_float4(g4[0], g4[1], g4[2], g4[3]);
    }
    __syncthreads();
  }
}

typedef float f32x2 __attribute__((ext_vector_type(2)));
__device__ __forceinline__ void ln_row_c(float (&y)[16], const float* __restrict__ g, const float* __restrict__ b, int lane,
                                         float* __restrict__ outf, u16* __restrict__ outb) {
  float s = 0.f;
#pragma unroll
  for (int i = 0; i < 16; ++i) s += y[i];
  const float mean = wave_sum(s) * (1.f / 1024.f);
  float q = 0.f;
#pragma unroll
  for (int i = 0; i < 16; ++i) { y[i] -= mean; q += y[i] * y[i]; }
  const float rstd = rsqrtf(wave_sum(q) * (1.f / 1024.f) + LN_EPS);
  const int c0 = lane * 16;
  unsigned pk[8];
#pragma unroll
  for (int q4 = 0; q4 < 4; ++q4) {
    const float4 gg = *(const float4*)(g + c0 + q4 * 4), bb = *(const float4*)(b + c0 + q4 * 4);
    float4 o;
    o.x = y[q4 * 4 + 0] * rstd * gg.x + bb.x; o.y = y[q4 * 4 + 1] * rstd * gg.y + bb.y;
    o.z = y[q4 * 4 + 2] * rstd * gg.z + bb.z; o.w = y[q4 * 4 + 3] * rstd * gg.w + bb.w;
    *(float4*)(outf + c0 + q4 * 4) = o;
    pk[q4 * 2] = cvtpk(o.x, o.y); pk[q4 * 2 + 1] = cvtpk(o.z, o.w);
  }
  if (outb) {
    *(uint4*)(outb + c0) = make_uint4(pk[0], pk[1], pk[2], pk[3]);
    *(uint4*)(outb + c0 + 8) = make_uint4(pk[4], pk[5], pk[6], pk[7]);
  }
}
#define EXP_LOAD(buf, tab, g_) do { const int ev_ = ((g_) < 8) ? e0 : e1; \
  _Pragma("unroll") for (int e_ = 0; e_ < 8; ++e_) { const int idx_ = __builtin_amdgcn_readlane(ev_, ((g_) & 7) * 8 + e_); \
    buf[e_] = *(const uint4*)((tab) + (size_t)idx_ * DM + lane * 16); } } while (0)
__device__ __forceinline__ float dot16_fp8(const uint4& w, const f32x2 (&x2)[8]) {
  f32x2 acc = {0.f, 0.f};
  acc += __builtin_amdgcn_cvt_pk_f32_fp8((int)w.x, false) * x2[0]; acc += __builtin_amdgcn_cvt_pk_f32_fp8((int)w.x, true) * x2[1];
  acc += __builtin_amdgcn_cvt_pk_f32_fp8((int)w.y, false) * x2[2]; acc += __builtin_amdgcn_cvt_pk_f32_fp8((int)w.y, true) * x2[3];
  acc += __builtin_amdgcn_cvt_pk_f32_fp8((int)w.z, false) * x2[4]; acc += __builtin_amdgcn_cvt_pk_f32_fp8((int)w.z, true) * x2[5];
  acc += __builtin_amdgcn_cvt_pk_f32_fp8((int)w.w, false) * x2[6]; acc += __builtin_amdgcn_cvt_pk_f32_fp8((int)w.w, true) * x2[7];
  return acc[0] + acc[1];
}
__device__ __forceinline__ void axpy16_fp8(const uint4& w, float c, f32x2 (&o2)[8]) {
  const f32x2 cc = {c, c};
  o2[0] += cc * __builtin_amdgcn_cvt_pk_f32_fp8((int)w.x, false); o2[1] += cc * __builtin_amdgcn_cvt_pk_f32_fp8((int)w.x, true);
  o2[2] += cc * __builtin_amdgcn_cvt_pk_f32_fp8((int)w.y, false); o2[3] += cc * __builtin_amdgcn_cvt_pk_f32_fp8((int)w.y, true);
  o2[4] += cc * __builtin_amdgcn_cvt_pk_f32_fp8((int)w.z, false); o2[5] += cc * __builtin_amdgcn_cvt_pk_f32_fp8((int)w.z, true);
  o2[6] += cc * __builtin_amdgcn_cvt_pk_f32_fp8((int)w.w, false); o2[7] += cc * __builtin_amdgcn_cvt_pk_f32_fp8((int)w.w, true);
}
__device__ __forceinline__ void phase_expert(const Params& p, int l, unsigned char* lds, bool last) {
  const int tid = ltid(), lane = tid & 63, wave = tid >> 6;
  float* c_w = (float*)lds + wave * 2048;
  int* sw = (int*)(lds + 32768) + wave * 384;
  const unsigned char* U8 = p.ws + WS_UB + (size_t)l * NEXP * DM;
  const unsigned char* V8 = p.ws + WS_VB + (size_t)l * NEXP * DM;
  const float* SU = (const float*)(p.ws + WS_SU) + (size_t)l * NEXP;
  const float* SV = (const float*)(p.ws + WS_SV) + (size_t)l * NEXP;
  const int* EIDX = (const int*)(p.ws + WS_EIDX); const float* GATE = (const float*)(p.ws + WS_GATE);
  int* EP = (int*)(p.ws + WS_QG);
  float* GP = (float*)(p.ws + WS_QG) + (size_t)T_TOK * 128;
  float* UP = (float*)(p.ws + WS_QG) + (size_t)2 * T_TOK * 128;
  float* H = (float*)(p.ws + WS_H); u16* HB = (u16*)(p.ws + WS_HB);
  const int eperm = ((lane & 1) << 2) | (((lane >> 1) & 1) << 1) | ((lane >> 2) & 1);
  const int tstep = gridDim.x * 4;
#define LOAD_X2(t_) do { const float* xr = H + (size_t)(t_) * DM + lane * 16; \
    _Pragma("unroll") for (int q4 = 0; q4 < 4; ++q4) { const float4 a = *(const float4*)(xr + q4 * 4); x2[q4 * 2] = (f32x2){a.x, a.y}; x2[q4 * 2 + 1] = (f32x2){a.z, a.w}; } } while (0)
#define LOAD_X2B(t_) do { const u16* xr = HB + (size_t)(t_) * DM + lane * 16; \
    const u32x4 w0 = *(const u32x4*)(xr), w1 = *(const u32x4*)(xr + 8); \
    x2[0] = (f32x2){bflo(w0.x), bfhi(w0.x)}; x2[1] = (f32x2){bflo(w0.y), bfhi(w0.y)}; x2[2] = (f32x2){bflo(w0.z), bfhi(w0.z)}; x2[3] = (f32x2){bflo(w0.w), bfhi(w0.w)}; \
    x2[4] = (f32x2){bflo(w1.x), bfhi(w1.x)}; x2[5] = (f32x2){bflo(w1.y), bfhi(w1.y)}; x2[6] = (f32x2){bflo(w1.z), bfhi(w1.z)}; x2[7] = (f32x2){bflo(w1.w), bfhi(w1.w)}; } while (0)
#define U_PART(gb, NP) do { uint4 ba[8], bb[8]; \
    EXP_LOAD(ba, U8, (gb)); \
    _Pragma("unroll") for (int gp = 0; gp < (NP); ++gp) { \
      _Pragma("unroll") for (int hh = 0; hh < 2; ++hh) { \
        const int grp = (gb) + gp * 2 + hh; \
        if (hh == 0) { EXP_LOAD(bb, U8, grp + 1); } else if (gp < (NP) - 1) { EXP_LOAD(ba, U8, grp + 1); } \
        float pd[8]; \
        _Pragma("unroll") for (int e = 0; e < 8; ++e) pd[e] = dot16_fp8(hh == 0 ? ba[e] : bb[e], x2); \
        float q4v[4], r2[2], s1; \
        const bool b0 = lane & 1, b1 = (lane >> 1) & 1, b2 = (lane >> 2) & 1; \
        _Pragma("unroll") for (int i = 0; i < 4; ++i) { const float keep = b0 ? pd[i + 4] : pd[i], send = b0 ? pd[i] : pd[i + 4]; q4v[i] = keep + __shfl_xor(send, 1); } \
        _Pragma("unroll") for (int i = 0; i < 2; ++i) { const float keep = b1 ? q4v[i + 2] : q4v[i], send = b1 ? q4v[i] : q4v[i + 2]; r2[i] = keep + __shfl_xor(send, 2); } \
        { const float keep = b2 ? r2[1] : r2[0], send = b2 ? r2[0] : r2[1]; s1 = keep + __shfl_xor(send, 4); } \
        s1 += __shfl_xor(s1, 8); s1 += __shfl_xor(s1, 16); s1 += __shfl_xor(s1, 32); \
        const float gate = __shfl((grp < 8) ? gv0 : gv1, (grp & 7) * 8 + eperm); \
        const float usc = __shfl((grp < 8) ? su0 : su1, (grp & 7) * 8 + eperm); \
        const float cval = gelu_f(s1 * usc) * gate; \
        if (lane < 8) c_s[grp * 8 + eperm] = cval; \
      } } } while (0)
#define V_HALF(gb, NP) do { uint4 ba[8], bb[8]; \
    EXP_LOAD(ba, V8, (gb)); \
    _Pragma("unroll 1") for (int gp = 0; gp < (NP); ++gp) { \
      _Pragma("unroll") for (int hh = 0; hh < 2; ++hh) { \
        const int grp = (gb) + gp * 2 + hh; \
        if (hh == 0) { EXP_LOAD(bb, V8, grp + 1); } else if (gp < (NP) - 1) { EXP_LOAD(ba, V8, grp + 1); } \
        _Pragma("unroll") for (int e = 0; e < 8; ++e) axpy16_fp8(hh == 0 ? ba[e] : bb[e], c_s[grp * 8 + e], o2); \
      } } } while (0)
  for (int tbase = blockIdx.x * 4 + wave; tbase < T_TOK; tbase += tstep * 16) {
    int slot = 0;
    for (int t = tbase; t < T_TOK && slot < 16; t += tstep, ++slot) {
      float* c_s = c_w + slot * 128;
      f32x2 x2[8];
      LOAD_X2B(t);
      const size_t eo0 = ((size_t)(lane >> 4) * T_TOK + t) * 16 + (lane & 15), eo1 = eo0 + (size_t)4 * T_TOK * 16;
      const int r0 = EIDX[eo0], r1 = EIDX[eo1];
      const float rg0 = GATE[eo0] * SV[r0], rg1 = GATE[eo1] * SV[r1], ru0 = SU[r0], ru1 = SU[r1];
      int e0, e1 = 0; float gv0, gv1 = 0.f, su0, su1 = 0.f;
      {
        const int q0 = r0 >> 12, q1 = r1 >> 12;
        const unsigned long long lt = (1ull << lane) - 1ull;
        int base = 0, pos0 = 0, pos1 = 0;
#pragma unroll
        for (int q = 0; q < 4; ++q) {
          const unsigned long long m0 = __ballot(q0 == q), m1 = __ballot(q1 == q);
          const int n0 = __popcll(m0), n1 = __popcll(m1);
          if (q0 == q) pos0 = base + __popcll(m0 & lt);
          if (q1 == q) pos1 = base + n0 + __popcll(m1 & lt);
          base += n0 + n1;
        }
        sw[pos0] = r0; sw[pos1] = r1;
        sw[128 + pos0] = __float_as_int(rg0); sw[128 + pos1] = __float_as_int(rg1);
        sw[256 + pos0] = __float_as_int(ru0); sw[256 + pos1] = __float_as_int(ru1);
        __builtin_amdgcn_fence(__ATOMIC_RELEASE, "workgroup");
        __builtin_amdgcn_wave_barrier();
        __builtin_amdgcn_fence(__ATOMIC_ACQUIRE, "workgroup");
        e0 = sw[lane]; const int e1p = sw[64 + lane];
        gv0 = __int_as_float(sw[128 + lane]); const float gv1p = __int_as_float(sw[192 + lane]);
        su0 = __int_as_float(sw[256 + lane]); const float su1p = __int_as_float(sw[320 + lane]);
        __builtin_amdgcn_fence(__ATOMIC_RELEASE, "workgroup");
        __builtin_amdgcn_wave_barrier();
        EP[(size_t)t * 128 + lane] = e0; EP[(size_t)t * 128 + 64 + lane] = e1p;
        GP[(size_t)t * 128 + lane] = gv0; GP[(size_t)t * 128 + 64 + lane] = gv1p;
        UP[(size_t)t * 128 + lane] = su0; UP[(size_t)t * 128 + 64 + lane] = su1p;
      }
      U_PART(0, 2);
    }
#pragma unroll 1
    for (int qtr = 1; qtr < 4; ++qtr) {
      slot = 0;
      for (int t = tbase; t < T_TOK && slot < 16; t += tstep, ++slot) {
        float* c_s = c_w + slot * 128;
        f32x2 x2[8];
        LOAD_X2B(t);
        const int hi = (qtr >= 2) ? 64 : 0;
        const int ev = EP[(size_t)t * 128 + hi + lane];
        const float gvv = GP[(size_t)t * 128 + hi + lane], suv = UP[(size_t)t * 128 + hi + lane];
        const int e0 = ev, e1 = ev; const float gv0 = gvv, gv1 = gvv, su0 = suv, su1 = suv;
        U_PART(qtr * 4, 2);
      }
    }
    __builtin_amdgcn_fence(__ATOMIC_RELEASE, "workgroup");
    __builtin_amdgcn_wave_barrier();
    __builtin_amdgcn_fence(__ATOMIC_ACQUIRE, "workgroup");
    slot = 0;
    for (int t = tbase; t < T_TOK && slot < 16; t += tstep, ++slot) {
      const float* c_s = c_w + slot * 128;
      f32x2 x2[8];
      LOAD_X2(t);
      const int e0 = EP[(size_t)t * 128 + lane], e1 = EP[(size_t)t * 128 + 64 + lane];
      f32x2 o2[8];
#pragma unroll
      for (int i = 0; i < 8; ++i) o2[i] = (f32x2){0.f, 0.f};
      V_HALF(0, 8);
      float o[16];
#pragma unroll
      for (int i = 0; i < 8; ++i) { o[2 * i] = o2[i][0] + ALPHA * x2[i][0]; o[2 * i + 1] = o2[i][1] + ALPHA * x2[i][1]; }
      if (last) ln_row_c(o, p.in[I_L2G] + (size_t)l * DM, p.in[I_L2B] + (size_t)l * DM, lane, p.out + (size_t)t * DM, (u16*)nullptr);
      else ln_row_c(o, p.in[I_L2G] + (size_t)l * DM, p.in[I_L2B] + (size_t)l * DM, lane, H + (size_t)t * DM, HB + (size_t)t * DM);
    }
    __builtin_amdgcn_fence(__ATOMIC_RELEASE, "workgroup");
    __builtin_amdgcn_wave_barrier();
  }
#undef LOAD_X2
#undef LOAD_X2B
#undef U_PART
#undef V_HALF
}

#define XB_TMO      128
#define XB_XCNT(j)  (256  + 64 * (j))
#define XB_XSUB(j)  (1280 + 64 * (j))
#define XB_XGEN(j)  (2304 + 64 * (j))
#define XB_TOP      3328
#define XB_TOPGEN   3392
#define XB_SPIN_CAP (1u << 20)
#define LAS __attribute__((address_space(3)))
__device__ __forceinline__ unsigned xb_ld(unsigned* p)              { return __hip_atomic_load(p, __ATOMIC_RELAXED, __HIP_MEMORY_SCOPE_AGENT); }
__device__ __forceinline__ unsigned xb_add(unsigned* p, unsigned v) { return __hip_atomic_fetch_add(p, v, __ATOMIC_RELAXED, __HIP_MEMORY_SCOPE_AGENT); }
__device__ __forceinline__ unsigned xb_xcc_id() { return (unsigned)__builtin_amdgcn_s_getreg((3 << 11) | 20) & 0xFu; }
#define XB_SPIN(cond, bar) do { unsigned _sp = 0; while (cond) { __builtin_amdgcn_s_sleep(1); \
    if ((++_sp & 255u) == 0u) { if (xb_ld(&(bar)[XB_TMO])) break; if (_sp > XB_SPIN_CAP) { atomicAdd(&(bar)[XB_TMO], 1u); break; } } } } while (0)
struct XcdBarrier { unsigned* bar; unsigned x; volatile LAS unsigned* st; };
__device__ __forceinline__ XcdBarrier xcd_barrier_post(unsigned* bar, volatile LAS unsigned* st) {
  XcdBarrier b; b.bar = bar; b.x = xb_xcc_id(); b.st = st;
  if (threadIdx.x == 0) (void)xb_add(&bar[XB_XCNT(b.x)], 1u);
  return b;
}
__device__ __forceinline__ void xcd_barrier_complete(unsigned* bar, unsigned x, unsigned& nloc, unsigned& nx) {
  const unsigned G = gridDim.x;
  unsigned sum, cnt, mine, sp = 0u;
  for (;;) {
    sum = 0u; cnt = 0u; mine = 0u;
#pragma unroll
    for (unsigned j = 0; j < 16; ++j) { const unsigned c = xb_ld(&bar[XB_XCNT(j)]); sum += c; cnt += (c > 0u) ? 1u : 0u; mine = (j == x) ? c : mine; }
    if (sum == G) break;
    __builtin_amdgcn_s_sleep(1);
    if ((++sp & 255u) == 0u) { if (xb_ld(&bar[XB_TMO])) break; if (sp > XB_SPIN_CAP) { atomicAdd(&bar[XB_TMO], 1u); break; } }
  }
  nloc = mine > 0u ? mine : 1u; nx = cnt > 0u ? cnt : 1u;
}
__device__ __forceinline__ void xcd_barrier(const XcdBarrier& b) {
  asm volatile("s_waitcnt vmcnt(0)" ::: "memory");
  __syncthreads();
  if (threadIdx.x == 0) {
    unsigned* bar = b.bar;
    __builtin_amdgcn_s_waitcnt(0);
    unsigned nloc = b.st[0], nx = b.st[1];
    if (nloc == 0u) { xcd_barrier_complete(bar, b.x, nloc, nx); b.st[0] = nloc; b.st[1] = nx; }
    const unsigned old = xb_add(&bar[XB_XSUB(b.x)], 1u);
    const unsigned gen = old / nloc;
    if (old + 1u == (gen + 1u) * nloc) {
      __builtin_amdgcn_fence(__ATOMIC_RELEASE, "agent");
      asm volatile("s_waitcnt vmcnt(0)" ::: "memory");
      const unsigned og = xb_add(&bar[XB_TOP], 1u);
      const unsigned tg = og / nx;
      if (og + 1u == (tg + 1u) * nx) xb_add(&bar[XB_TOPGEN], 1u);
      else XB_SPIN(xb_ld(&bar[XB_TOPGEN]) == tg, bar);
      __builtin_amdgcn_fence(__ATOMIC_ACQUIRE, "agent");
      xb_add(&bar[XB_XGEN(b.x)], 1u);
      asm volatile("s_waitcnt vmcnt(0)" ::: "memory");
    } else {
      XB_SPIN(xb_ld(&bar[XB_XGEN(b.x)]) == gen, bar);
      __builtin_amdgcn_fence(__ATOMIC_ACQUIRE, "agent");
      asm volatile("s_waitcnt vmcnt(0)" ::: "memory");
    }
  }
  __syncthreads();
}
__global__ void __launch_bounds__(256, 2) fwd_mega(Params p) {
  extern __shared__ __attribute__((aligned(16))) unsigned char lds[];
  cg::grid_group grid = cg::this_grid();
  if (p.ph_lo < 0) grid.sync();
  volatile LAS unsigned* xb_st = (volatile LAS unsigned*)(LAS unsigned char*)(lds + LDS_BYTES - 16);
  if (threadIdx.x == 0) { xb_st[0] = 0u; xb_st[1] = 0u; }
  __syncthreads();
  const XcdBarrier xbar = xcd_barrier_post((unsigned*)(p.ws + WS_XBAR), xb_st);
  for (int ph = p.ph_lo; ph < p.ph_hi; ++ph) {
    if (ph == 0) {
      phase_prologue(p, lds);
    } else {
      const int l = (ph - 1) / 9, sub = (ph - 1) % 9;
      if (sub == 0) { phase_inproj(p, l, lds); }
      else if (sub == 1) {
        for (int it = blockIdx.x; it < 1536; it += gridDim.x) { if (it < 512) sgu_item(p, l, it, lds); else gla_passA_item(p, l, it - 512, lds); }
      }
      else if (sub == 2) { for (int it = blockIdx.x; it < 1024; it += gridDim.x) scan_item(p, it); }
      else if (sub == 3) { for (int it = blockIdx.x; it < 1024; it += gridDim.x) gla_passC_item(p, l, it, lds); }
      else if (sub == 4) { phase_outproj(p, l, lds); }
      else if (sub == 5) { phase_ln1(p, l); }
      else if (sub == 6) { phase_q(p, l, lds, (u16*)(p.ws + WS_QG)); }
      else if (sub == 7) { phase_route(p, l, lds, (const u16*)(p.ws + WS_QG)); }
      else { phase_expert(p, l, lds, l == NL - 1); }
    }
    if (ph + 1 < p.ph_hi) xcd_barrier(xbar);
  }
}

extern "C" void kernel_launch(void* const* d_in, const int* in_sizes, int n_in,
                              void* d_out, int out_size, void* d_ws, size_t ws_size,
                              hipStream_t stream) {
  static int grid_blocks = 0;
  if (!grid_blocks) {
    if (n_in != 21 || out_size != T_TOK * DM || ws_size < WS_END) {
      fprintf(stderr, "kernel_launch: unexpected shapes n_in=%d out=%d ws=%zu (need %zu)\n", n_in, out_size, ws_size, (size_t)WS_END);
      grid_blocks = -1; return;
    }
    int dev = 0, cus = 0, per_cu = 0;
    (void)hipGetDevice(&dev);
    (void)hipDeviceGetAttribute(&cus, hipDeviceAttributeMultiprocessorCount, dev);
    (void)hipFuncSetAttribute((const void*)fwd_mega, hipFuncAttributeMaxDynamicSharedMemorySize, LDS_BYTES);
    (void)hipOccupancyMaxActiveBlocksPerMultiprocessor(&per_cu, (const void*)fwd_mega, 256, LDS_BYTES);
    if (per_cu < 1) per_cu = 1;
    if (per_cu > 2) per_cu = 2;
    grid_blocks = cus * per_cu;
    fprintf(stderr, "kernel_launch: grid %d (cus %d x %d)\n", grid_blocks, cus, per_cu);
  }
  if (grid_blocks < 0) return;
  Params p{};
  for (int i = 0; i < 21; ++i) p.in[i] = (const float*)d_in[i];
  p.out = (float*)d_out; p.ws = (unsigned char*)d_ws; p.ph_lo = 0; p.ph_hi = NPHASE;
  (void)hipMemsetAsync((unsigned char*)d_ws + WS_BAR, 0, 16384, stream);
  void* args[] = {&p};
  hipError_t e = hipLaunchCooperativeKernel((void*)fwd_mega, dim3(grid_blocks), dim3(256), args, LDS_BYTES, stream);
  if (e != hipSuccess) fprintf(stderr, "cooperative launch failed: %s (grid %d)\n", hipGetErrorString(e), grid_blocks);
}
```
